# Optimizing an MI355X kernel written in HIP

```python
import math
import jax, jax.numpy as jnp
from jax import lax
import numpy as np

D_MODEL = 1024
BATCH = 4
SEQ = 4096
DEPTH = 1

PLE_DIM = 256
ROPE_THETA = 10000.0
Q_BLOCK = 128
LN_EPS = 1e-5
RMS_EPS = 1e-6
NEG_INF = -1e30
MAX_POS_OFFSET = 1024

DIFF_HEADS = 8
DIFF_HEAD_DIM = 64
DIFF_QK_WIDTH = 2 * DIFF_HEADS * DIFF_HEAD_DIM
DIFF_WIDTH = DIFF_HEADS * 2 * DIFF_HEAD_DIM

MLA_HEADS = 8
MLA_Q_LORA = 384
MLA_KV_LORA = 256
MLA_NOPE = 128
MLA_ROPE = 64
MLA_V = 128
MLA_WIDTH = MLA_HEADS * MLA_V

IN_SPLIT_SIZES = (DIFF_QK_WIDTH, DIFF_QK_WIDTH, DIFF_WIDTH, DIFF_WIDTH,
                  MLA_Q_LORA, MLA_KV_LORA, MLA_ROPE, MLA_WIDTH, 2 * D_MODEL)
N_IN = sum(IN_SPLIT_SIZES)

DEEPNORM_ALPHA = (2 * DEPTH) ** 0.25
DEEPNORM_BETA = (8 * DEPTH) ** -0.25

kernel_name = "diffattn_mla_gated_hybrid_deepnorm"


def layer_norm(x, g, b):
    xf = x.astype(jnp.float32)
    mu = jnp.mean(xf, -1, keepdims=True)
    var = jnp.mean(jnp.square(xf - mu), -1, keepdims=True)
    return ((xf - mu) * lax.rsqrt(var + LN_EPS) * g + b).astype(x.dtype)


def rms_norm(x, g):
    xf = x.astype(jnp.float32)
    y = xf * lax.rsqrt(jnp.mean(xf * xf, -1, keepdims=True) + RMS_EPS)
    return (y * g).astype(x.dtype)


def rope(x, positions):
    dim = x.shape[-1]
    inv = ROPE_THETA ** (-jnp.arange(0, dim, 2, dtype=jnp.float32) / dim)
    ang = positions.astype(jnp.float32)[:, None, :, None] * inv
    cos, sin = jnp.cos(ang), jnp.sin(ang)
    x1, x2 = jnp.split(x.astype(jnp.float32), 2, axis=-1)
    return jnp.concatenate([x1 * cos - x2 * sin, x2 * cos + x1 * sin], -1).astype(x.dtype)


def _query_blocks(t, seq_axis):
    nb = t.shape[seq_axis] // Q_BLOCK
    t = t.reshape(t.shape[:seq_axis] + (nb, Q_BLOCK) + t.shape[seq_axis + 1:])
    return jnp.moveaxis(t, seq_axis, 0)


def _causal_mask(block_idx, seq):
    q_pos = block_idx * Q_BLOCK + jnp.arange(Q_BLOCK)
    return jnp.arange(seq)[None, :] <= q_pos[:, None]


def diff_attention(q, k, v, lam):
    S = q.shape[3]
    scale = DIFF_HEAD_DIM ** -0.5
    qb = _query_blocks(q, 3)

    def one_block(args):
        q_blk, i = args
        s = jnp.einsum('bhcqd,bhckd->bhcqk', q_blk, k).astype(jnp.float32) * scale
        s = jnp.where(_causal_mask(i, S), s, NEG_INF)
        pr = jax.nn.softmax(s, axis=-1)
        w = (pr[:, :, 0] - lam * pr[:, :, 1]).astype(v.dtype)
        return jnp.einsum('bhqk,bhkd->bhqd', w, v)

    o = lax.map(one_block, (qb, jnp.arange(qb.shape[0])))
    _, B, H, _, dv = o.shape
    return jnp.moveaxis(o, 0, 2).reshape(B, H, S, dv)


def mla_attention(q_nope, q_pe, k_nope, k_pe, v):
    S = q_nope.shape[2]
    scale = (MLA_NOPE + MLA_ROPE) ** -0.5
    qn_b = _query_blocks(q_nope, 2)
    qp_b = _query_blocks(q_pe, 2)

    def one_block(args):
        qn, qp, i = args
        s = (jnp.einsum('bhqd,bhkd->bhqk', qn, k_nope)
             + jnp.einsum('bhqr,bkr->bhqk', qp, k_pe)).astype(jnp.float32) * scale
        s = jnp.where(_causal_mask(i, S), s, NEG_INF)
        pr = jax.nn.softmax(s, axis=-1).astype(v.dtype)
        return jnp.einsum('bhqk,bhkd->bhqd', pr, v)

    o = lax.map(one_block, (qn_b, qp_b, jnp.arange(qn_b.shape[0])))
    _, B, H, _, dv = o.shape
    return jnp.moveaxis(o, 0, 2).reshape(B, H, S, dv)


def setup_inputs(seed: int = 0) -> dict:
    key = jax.random.key(seed)
    ks = jax.random.split(key, 24)
    f32 = jnp.float32
    D = D_MODEL

    def nrm(k, shape, scale):
        return jax.random.normal(k, shape, f32) * scale

    x = nrm(ks[0], (BATCH, SEQ, D), 1.0)
    p = nrm(ks[1], (DEPTH, BATCH, SEQ, PLE_DIM), 1.0)
    positions = (jax.random.randint(ks[2], (BATCH, 1), 0, MAX_POS_OFFSET)
                 + jnp.arange(SEQ)[None, :]).astype(jnp.int32)
    return {
        "x": x,
        "p": p,
        "positions": positions,
        "ln_emb_g": 1.0 + nrm(ks[3], (D,), 0.02),
        "ln_emb_b": nrm(ks[4], (D,), 0.02),
        "w_in": nrm(ks[5], (DEPTH, D, N_IN), D ** -0.5),
        "b_gate": nrm(ks[6], (DEPTH, 2 * D), 0.02),
        "diff_lambda": nrm(ks[7], (DEPTH, 4, DIFF_HEAD_DIM), 0.1),
        "diff_subln_g": 1.0 + nrm(ks[8], (DEPTH, 2 * DIFF_HEAD_DIM), 0.02),
        "w_o_a": nrm(ks[9], (DEPTH, DIFF_WIDTH, D), DIFF_WIDTH ** -0.5 * DEEPNORM_BETA),
        "mla_q_norm_g": 1.0 + nrm(ks[10], (DEPTH, MLA_Q_LORA), 0.02),
        "mla_w_uq": nrm(ks[11], (DEPTH, MLA_Q_LORA, MLA_HEADS * (MLA_NOPE + MLA_ROPE)), MLA_Q_LORA ** -0.5),
        "mla_kv_norm_g": 1.0 + nrm(ks[12], (DEPTH, MLA_KV_LORA), 0.02),
        "mla_w_ukv": nrm(ks[13], (DEPTH, MLA_KV_LORA, MLA_HEADS * (MLA_NOPE + MLA_V)), MLA_KV_LORA ** -0.5),
        "w_o_b": nrm(ks[14], (DEPTH, MLA_WIDTH, D), MLA_WIDTH ** -0.5 * DEEPNORM_BETA),
        "w_out": nrm(ks[15], (DEPTH, D, D), D ** -0.5 * DEEPNORM_BETA),
        "ple_w_gate": nrm(ks[16], (DEPTH, D, D), D ** -0.5),
        "ple_b_gate": nrm(ks[17], (DEPTH, D), 0.02),
        "ple_w_proj": nrm(ks[18], (DEPTH, PLE_DIM, D), PLE_DIM ** -0.5 * DEEPNORM_BETA),
        "ln_post_g": 1.0 + nrm(ks[19], (DEPTH, D), 0.02),
        "ln_post_b": nrm(ks[20], (DEPTH, D), 0.02),
    }


def reference(x, p, positions, ln_emb_g, ln_emb_b, w_in, b_gate, diff_lambda, diff_subln_g,
              w_o_a, mla_q_norm_g, mla_w_uq, mla_kv_norm_g, mla_w_ukv, w_o_b, w_out,
              ple_w_gate, ple_b_gate, ple_w_proj, ln_post_g, ln_post_b):
    B, S, D = x.shape
    split_idx = [int(v) for v in np.cumsum(IN_SPLIT_SIZES)[:-1]]
    x = layer_norm(x, ln_emb_g, ln_emb_b)

    for i in range(DEPTH):
        h = x @ w_in[i]
        q_a, k_a, v_a, z_a, c_q, c_kv, k_pe, z_b, g_logit = jnp.split(h, split_idx, axis=-1)

        def heads2(t):
            t = t.reshape(B, S, 2 * DIFF_HEADS, DIFF_HEAD_DIM).transpose(0, 2, 1, 3)
            return rope(t, positions).reshape(B, DIFF_HEADS, 2, S, DIFF_HEAD_DIM)
        qa, ka = heads2(q_a), heads2(k_a)
        va = v_a.reshape(B, S, DIFF_HEADS, 2 * DIFF_HEAD_DIM).transpose(0, 2, 1, 3)
        lam_init = 0.8 - 0.6 * math.exp(-0.3 * i)
        lq = diff_lambda[i].astype(jnp.float32)
        lam = jnp.exp(jnp.sum(lq[0] * lq[1])) - jnp.exp(jnp.sum(lq[2] * lq[3])) + lam_init
        o_a = diff_attention(qa, ka, va, lam)
        o_a = rms_norm(o_a, diff_subln_g[i]) * (1.0 - lam_init)
        o_a = o_a.transpose(0, 2, 1, 3).reshape(B, S, DIFF_WIDTH)
        y_a = (o_a * jax.nn.silu(z_a)) @ w_o_a[i]

        qb = (rms_norm(c_q, mla_q_norm_g[i]) @ mla_w_uq[i])
        qb = qb.reshape(B, S, MLA_HEADS, MLA_NOPE + MLA_ROPE).transpose(0, 2, 1, 3)
        q_nope, q_pe = qb[..., :MLA_NOPE], rope(qb[..., MLA_NOPE:], positions)
        kv = (rms_norm(c_kv, mla_kv_norm_g[i]) @ mla_w_ukv[i])
        kv = kv.reshape(B, S, MLA_HEADS, MLA_NOPE + MLA_V).transpose(0, 2, 1, 3)
        k_nope, v_b = kv[..., :MLA_NOPE], kv[..., MLA_NOPE:]
        k_rot = rope(k_pe[:, None], positions)[:, 0]
        o_b = mla_attention(q_nope, q_pe, k_nope, k_rot, v_b)
        o_b = o_b.transpose(0, 2, 1, 3).reshape(B, S, MLA_WIDTH)
        y_b = (o_b * jax.nn.silu(z_b)) @ w_o_b[i]

        g_a, g_b = jnp.split(jax.nn.sigmoid(g_logit + b_gate[i]), 2, axis=-1)
        mix = (g_a * y_a + g_b * y_b) @ w_out[i]

        y = DEEPNORM_ALPHA * x + mix
        y = y + jax.nn.sigmoid(y @ ple_w_gate[i] + ple_b_gate[i]) * (p[i] @ ple_w_proj[i])
        x = layer_norm(y, ln_post_g[i], ln_post_b[i])

    return x
```

```cpp
#include <hip/hip_runtime.h>
#include <cstdint>
#include <cstdio>

typedef unsigned short bf16_t;
typedef unsigned u32x4 __attribute__((ext_vector_type(4)));
typedef float f32x4 __attribute__((ext_vector_type(4)));

constexpr int NB = 4, SEQ = 4096, T = NB * SEQ, DM = 1024, PLE = 256, NIN = 7872;
constexpr int C_QA = 0, C_KA = 1024, C_VA = 2048, C_ZA = 3072, C_CQ = 4096, C_CKV = 4480, C_KPE = 4736, C_ZB = 4800, C_G = 5824;
constexpr int QL = 384, KVL = 256, NUQ = 1536, NUKV = 2048;
constexpr float LN_EPS = 1e-5f, RMS_EPS = 1e-6f;
constexpr float LOG2E = 1.4426950408889634f;
constexpr float SC_A = 0.125f * LOG2E;
constexpr float SC_B = 0.07216878364870322f * LOG2E;
constexpr float ALPHA = 1.189207115002721f;
constexpr float LAM_INIT = 0.2f;

constexpr size_t MiB = 1u << 20;
constexpr size_t WS_CTL = 0;
constexpr size_t WS_ESTAT = 1 * MiB;
constexpr size_t WS_RQ = 1 * MiB + 256 * 1024;
constexpr size_t WS_RKV = 1 * MiB + 512 * 1024;
constexpr size_t WS_WOA = 2 * MiB, WS_WOB = 4 * MiB, WS_WOUT = 6 * MiB, WS_WPG = 8 * MiB;
constexpr size_t WS_WUQ = 10 * MiB, WS_WUKV = 11 * MiB + 256 * 1024, WS_WPP = 12 * MiB + 512 * 1024;
constexpr size_t WS_COS = 13 * MiB, WS_SIN = 15 * MiB;
constexpr size_t WS_PB = 17 * MiB;
constexpr size_t WS_KROT = 25 * MiB;
constexpr size_t WS_CQ = 27 * MiB, WS_CKV = 39 * MiB;
constexpr size_t WS_WIN = 47 * MiB;
constexpr size_t WS_XN = 63 * MiB;
constexpr size_t WS_QA = 95 * MiB, WS_KA = 127 * MiB, WS_VA = 159 * MiB, WS_SZA = 191 * MiB, WS_SZB = 223 * MiB;
constexpr size_t WS_AA = WS_QA;
constexpr size_t WS_STASH = WS_XN;
constexpr size_t WS_QN = 127 * MiB;
constexpr size_t WS_KN = 175 * MiB;
constexpr size_t WS_VB = 63 * MiB;
constexpr size_t WS_AB = 27 * MiB;
constexpr size_t WS_U = 127 * MiB;
constexpr size_t WS_Y = 159 * MiB;
constexpr size_t WS_YB = 223 * MiB;
constexpr size_t WS_PP = 63 * MiB;
constexpr size_t WS_END = 255 * MiB;

__device__ __forceinline__ float bf2f(bf16_t v) { return __uint_as_float((unsigned)v << 16); }
__device__ __forceinline__ bf16_t f2bf(float f) { unsigned u = __float_as_uint(f); return (bf16_t)((u + 0x7fffu + ((u >> 16) & 1u)) >> 16); }
__device__ __forceinline__ float sigmoidf_(float v) { return 1.0f / (1.0f + __expf(-v)); }
__device__ __forceinline__ float siluf_(float v) { return v / (1.0f + __expf(-v)); }

__device__ const double INVF[32] = {1.0, 0.7498942093324559, 0.5623413251903491, 0.4216965034285822, 0.31622776601683794, 0.23713737056616552, 0.1778279410038923, 0.1333521432163324, 0.1, 0.07498942093324558, 0.05623413251903491, 0.042169650342858224, 0.03162277660168379, 0.023713737056616554, 0.01778279410038923, 0.01333521432163324, 0.01, 0.007498942093324558, 0.005623413251903491, 0.004216965034285823, 0.0031622776601683794, 0.0023713737056616554, 0.0017782794100389228, 0.001333521432163324, 0.001, 0.0007498942093324559, 0.0005623413251903491, 0.00042169650342858224, 0.00031622776601683794, 0.00023713737056616554, 0.00017782794100389227, 0.0001333521432163324};

__device__ __forceinline__ void rope_cs(int pos, int i, float& c, float& s) {
    const float invf = (float)INVF[i]; const float angf = (float)pos * invf;
    double t = (double)angf * 0.15915494309189535; t -= floor(t);
    const double r = t * 4.0; const double qd = floor(r + 0.5); const double f = (r - qd) * 1.5707963267948966; const int q = ((int)qd) & 3;
    const double f2 = f * f;
    double sp = -1.0 / 6227020800.0; sp = sp * f2 + 1.0 / 39916800.0; sp = sp * f2 - 1.0 / 362880.0; sp = sp * f2 + 1.0 / 5040.0; sp = sp * f2 - 1.0 / 120.0; sp = sp * f2 + 1.0 / 6.0;
    const double sn = f - f * f2 * sp;
    double cp = 1.0 / 87178291200.0; cp = cp * f2 - 1.0 / 479001600.0; cp = cp * f2 + 1.0 / 3628800.0; cp = cp * f2 - 1.0 / 40320.0; cp = cp * f2 + 1.0 / 720.0; cp = cp * f2 - 1.0 / 24.0; cp = cp * f2 + 0.5;
    const double cs = 1.0 - f2 * cp;
    double so, co;
    if (q == 0) { so = sn; co = cs; } else if (q == 1) { so = cs; co = -sn; } else if (q == 2) { so = -sn; co = -cs; } else { so = -cs; co = sn; }
    c = (float)co; s = (float)so;
}

struct Ptrs {
    const float *x, *p; const int* pos; const float *ln_emb_g, *ln_emb_b, *w_in, *b_gate, *diff_lambda, *subln_g, *w_o_a, *q_norm_g, *w_uq, *kv_norm_g, *w_ukv, *w_o_b, *w_out, *w_pg, *b_pg, *w_pp, *ln_post_g, *ln_post_b;
    float* out; unsigned char* ws;
};

__global__ void k_rope_tab(Ptrs P) {
    const int idx = blockIdx.x * blockDim.x + threadIdx.x; if (idx >= T * 32) return;
    const int t = idx >> 5, i = idx & 31; float c, s; rope_cs(P.pos[t], i, c, s);
    ((float*)(P.ws + WS_COS))[idx] = c; ((float*)(P.ws + WS_SIN))[idx] = s;
}
__global__ void k_p_bf16(Ptrs P) {
    const int idx = blockIdx.x * blockDim.x + threadIdx.x; if (idx >= T * PLE) return;
    ((bf16_t*)(P.ws + WS_PB))[idx] = f2bf(P.p[idx]);
}
__device__ __forceinline__ float wave_sum(float v) {
#pragma unroll
    for (int o = 1; o < 64; o <<= 1) v += __shfl_xor(v, o);
    return v;
}
__global__ void k_ln_emb(Ptrs P) {
    const int row = blockIdx.x * 4 + (threadIdx.x >> 6), lane = threadIdx.x & 63;
    const f32x4* xr = (const f32x4*)(P.x + (size_t)row * DM) + lane;
    f32x4 v[4]; float s = 0.f;
#pragma unroll
    for (int j = 0; j < 4; ++j) { v[j] = xr[64 * j]; s += (v[j].x + v[j].y) + (v[j].z + v[j].w); }
    const float mean = wave_sum(s) * (1.f / DM); float s2 = 0.f;
#pragma unroll
    for (int j = 0; j < 4; ++j) { v[j] = v[j] - mean; s2 += (v[j].x * v[j].x + v[j].y * v[j].y) + (v[j].z * v[j].z + v[j].w * v[j].w); }
    const float rstd = 1.f / sqrtf(wave_sum(s2) * (1.f / DM) + LN_EPS);
    bf16_t* o = (bf16_t*)(P.ws + WS_XN) + (size_t)row * DM;
#pragma unroll
    for (int j = 0; j < 4; ++j) { const int c = 256 * j + 4 * lane; const f32x4 g = *(const f32x4*)(P.ln_emb_g + c), b = *(const f32x4*)(P.ln_emb_b + c);
        o[c] = f2bf(v[j].x * rstd * g.x + b.x); o[c + 1] = f2bf(v[j].y * rstd * g.y + b.y); o[c + 2] = f2bf(v[j].z * rstd * g.z + b.z); o[c + 3] = f2bf(v[j].w * rstd * g.w + b.w); }
    if (lane == 0) { float* st = (float*)(P.ws + WS_ESTAT) + 2 * row; st[0] = mean; st[1] = rstd; }
}
template <int K>
__device__ __forceinline__ void ndot8(const bf16_t* __restrict__ A, int row0, const float* __restrict__ W, int ldw, int col, float (&acc)[8]) {
    for (int k = 0; k < K; k += 8) {
        float w[8];
#pragma unroll
        for (int j = 0; j < 8; ++j) w[j] = W[(size_t)(k + j) * ldw + col];
#pragma unroll
        for (int r = 0; r < 8; ++r) { const u32x4 a = *(const u32x4*)(A + (size_t)(row0 + r) * K + k);
            acc[r] += __uint_as_float(a.x << 16) * w[0] + __uint_as_float(a.x & 0xffff0000u) * w[1] + __uint_as_float(a.y << 16) * w[2] + __uint_as_float(a.y & 0xffff0000u) * w[3]
                    + __uint_as_float(a.z << 16) * w[4] + __uint_as_float(a.z & 0xffff0000u) * w[5] + __uint_as_float(a.w << 16) * w[6] + __uint_as_float(a.w & 0xffff0000u) * w[7]; }
    }
}
__global__ void __launch_bounds__(256) k_n_win(Ptrs P) {
    const int w = blockIdx.x * 256 + threadIdx.x, row0 = blockIdx.y * 8; if (w >= 6816) return;
    const bf16_t* XN = (const bf16_t*)(P.ws + WS_XN);
    int c1, c2 = -1;
    if (w < 512) { c1 = C_QA + 64 * (w >> 5) + (w & 31); c2 = c1 + 32; }
    else if (w < 1024) { const int u = w - 512; c1 = C_KA + 64 * (u >> 5) + (u & 31); c2 = c1 + 32; }
    else if (w < 1056) { c1 = C_KPE + (w - 1024); c2 = c1 + 32; }
    else { const int u = w - 1056; c1 = u < 2688 ? C_VA + u : C_ZB + (u - 2688); }
    float a1[8] = {0, 0, 0, 0, 0, 0, 0, 0}, a2[8] = {0, 0, 0, 0, 0, 0, 0, 0};
    ndot8<DM>(XN, row0, P.w_in, NIN, c1, a1);
    if (c2 >= 0) ndot8<DM>(XN, row0, P.w_in, NIN, c2, a2);
    const float* COS = (const float*)(P.ws + WS_COS); const float* SIN = (const float*)(P.ws + WS_SIN);
#pragma unroll
    for (int r = 0; r < 8; ++r) { const int row = row0 + r; const float v = a1[r];
        if (c2 >= 0) { const int i = c1 & 31; const float cs = COS[row * 32 + i], sn = SIN[row * 32 + i]; float o1 = v * cs - a2[r] * sn, o2 = a2[r] * cs + v * sn;
            if (c1 < C_KA) { bf16_t* q = (bf16_t*)(P.ws + WS_QA) + (size_t)row * DM; q[c1] = f2bf(o1 * SC_A); q[c2] = f2bf(o2 * SC_A); }
            else if (c1 < C_VA) { bf16_t* q = (bf16_t*)(P.ws + WS_KA) + (size_t)row * DM; q[c1 - C_KA] = f2bf(o1); q[c2 - C_KA] = f2bf(o2); }
            else { bf16_t* q = (bf16_t*)(P.ws + WS_KROT) + (size_t)row * 64; q[c1 - C_KPE] = f2bf(o1); q[c2 - C_KPE] = f2bf(o2); } }
        else if (c1 < C_ZA) ((bf16_t*)(P.ws + WS_VA))[(size_t)row * DM + (c1 - C_VA)] = f2bf(v);
        else if (c1 < C_CQ) ((bf16_t*)(P.ws + WS_SZA))[(size_t)row * DM + (c1 - C_ZA)] = f2bf(siluf_(v));
        else if (c1 < C_CKV) ((bf16_t*)(P.ws + WS_CQ))[(size_t)row * QL + (c1 - C_CQ)] = f2bf(v);
        else if (c1 < C_KPE) ((bf16_t*)(P.ws + WS_CKV))[(size_t)row * KVL + (c1 - C_CKV)] = f2bf(v);
        else if (c1 < C_G) ((bf16_t*)(P.ws + WS_SZB))[(size_t)row * DM + (c1 - C_ZB)] = f2bf(siluf_(v));
        else ((bf16_t*)P.out)[(size_t)row * 2048 + (c1 - C_G)] = f2bf(sigmoidf_(v + P.b_gate[c1 - C_G])); }
}
__global__ void k_n_rstd(Ptrs P) {
    const int row = blockIdx.x * blockDim.x + threadIdx.x; if (row >= T) return;
    const bf16_t* cq = (const bf16_t*)(P.ws + WS_CQ) + (size_t)row * QL; float s = 0.f;
    for (int k = 0; k < QL; ++k) { const float v = bf2f(cq[k]); s += v * v; }
    ((float*)(P.ws + WS_RQ))[row] = 1.f / sqrtf(s * (1.f / QL) + RMS_EPS);
    const bf16_t* ck = (const bf16_t*)(P.ws + WS_CKV) + (size_t)row * KVL; s = 0.f;
    for (int k = 0; k < KVL; ++k) { const float v = bf2f(ck[k]); s += v * v; }
    ((float*)(P.ws + WS_RKV))[row] = 1.f / sqrtf(s * (1.f / KVL) + RMS_EPS);
}
template <int MODE>
__global__ void __launch_bounds__(256) k_n_attn(Ptrs P) {
    constexpr int DQK = MODE == 0 ? 64 : 192;
    const int bh = blockIdx.y, b = bh >> 3, h = bh & 7, qi = blockIdx.x * 64 + (threadIdx.x >> 2), ch = threadIdx.x & 3;
    const size_t trow = (size_t)b * SEQ + qi;
    const bf16_t* Vb = MODE == 0 ? (const bf16_t*)(P.ws + WS_VA) : (const bf16_t*)(P.ws + WS_VB);
    float o1n[32];
    float lam = 0.f;
    if (MODE == 0) { float s1 = 0.f, s2 = 0.f; for (int k = 0; k < 64; ++k) { s1 += P.diff_lambda[k] * P.diff_lambda[64 + k]; s2 += P.diff_lambda[128 + k] * P.diff_lambda[192 + k]; } lam = __expf(s1) - __expf(s2) + LAM_INIT; }
    constexpr int NPASS = MODE == 0 ? 2 : 1;
    float on[32];
#pragma unroll 1
    for (int pass = 0; pass < NPASS; ++pass) {
        unsigned qp[DQK / 2];
        const bf16_t* qsrc = MODE == 0 ? (const bf16_t*)(P.ws + WS_QA) + trow * DM + 128 * h + 64 * pass : (const bf16_t*)(P.ws + WS_QN) + trow * NUQ + 192 * h;
#pragma unroll
        for (int d = 0; d < DQK / 2; ++d) qp[d] = ((const unsigned*)qsrc)[d];
        float o[32]; float m = -1e30f, l = 0.f;
#pragma unroll
        for (int c = 0; c < 32; ++c) o[c] = 0.f;
        for (int j = 0; j <= qi; ++j) {
            const size_t krow = (size_t)b * SEQ + j; float s = 0.f;
            if (MODE == 0) { const unsigned* kp = (const unsigned*)((const bf16_t*)(P.ws + WS_KA) + krow * DM + 128 * h + 64 * pass);
#pragma unroll
                for (int d = 0; d < 32; ++d) { const unsigned kv = kp[d]; s += __uint_as_float(qp[d] << 16) * __uint_as_float(kv << 16) + __uint_as_float(qp[d] & 0xffff0000u) * __uint_as_float(kv & 0xffff0000u); } }
            else { const unsigned* kp = (const unsigned*)((const bf16_t*)(P.ws + WS_KN) + krow * DM + 128 * h);
#pragma unroll
                for (int d = 0; d < 64; ++d) { const unsigned kv = kp[d]; s += __uint_as_float(qp[d] << 16) * __uint_as_float(kv << 16) + __uint_as_float(qp[d] & 0xffff0000u) * __uint_as_float(kv & 0xffff0000u); }
                const unsigned* kr = (const unsigned*)((const bf16_t*)(P.ws + WS_KROT) + krow * 64);
#pragma unroll
                for (int d = 0; d < 32; ++d) { const unsigned kv = kr[d]; s += __uint_as_float(qp[64 + d] << 16) * __uint_as_float(kv << 16) + __uint_as_float(qp[64 + d] & 0xffff0000u) * __uint_as_float(kv & 0xffff0000u); } }
            const float mn = fmaxf(m, s), corr = exp2f(m - mn), pj = exp2f(s - mn); m = mn; l = l * corr + pj;
            const unsigned* vp = (const unsigned*)(Vb + krow * DM + 128 * h + 32 * ch);
#pragma unroll
            for (int c = 0; c < 16; ++c) { const unsigned vv = vp[c]; o[2 * c] = o[2 * c] * corr + pj * __uint_as_float(vv << 16); o[2 * c + 1] = o[2 * c + 1] * corr + pj * __uint_as_float(vv & 0xffff0000u); }
        }
        const float rl = 1.f / l;
#pragma unroll
        for (int c = 0; c < 32; ++c) { on[c] = o[c] * rl; if (pass == 0) o1n[c] = on[c]; }
    }
    if (MODE == 0) {
        float ss = 0.f;
#pragma unroll
        for (int c = 0; c < 32; ++c) { on[c] = o1n[c] - lam * on[c]; ss += on[c] * on[c]; }
        ss += __shfl_xor(ss, 1); ss += __shfl_xor(ss, 2);
        const float rs = 1.f / sqrtf(ss * (1.f / 128.f) + RMS_EPS);
        const bf16_t* sz = (const bf16_t*)(P.ws + WS_SZA) + trow * DM + 128 * h + 32 * ch; bf16_t* dst = (bf16_t*)(P.ws + WS_AA) + trow * DM + 128 * h + 32 * ch;
#pragma unroll
        for (int c = 0; c < 32; ++c) dst[c] = f2bf(on[c] * rs * P.subln_g[32 * ch + c] * (1.f - LAM_INIT) * bf2f(sz[c]));
    } else {
        const bf16_t* sz = (const bf16_t*)(P.ws + WS_SZB) + trow * DM + 128 * h + 32 * ch; bf16_t* dst = (bf16_t*)(P.ws + WS_AB) + trow * DM + 128 * h + 32 * ch;
#pragma unroll
        for (int c = 0; c < 32; ++c) dst[c] = f2bf(on[c] * bf2f(sz[c]));
    }
}
__global__ void __launch_bounds__(256) k_n_up(Ptrs P) {
    const int w = blockIdx.x * 256 + threadIdx.x, row0 = blockIdx.y * 8;
    if (w >= 1024 + 256 + 2048) return;
    const float* COS = (const float*)(P.ws + WS_COS); const float* SIN = (const float*)(P.ws + WS_SIN);
    const float* RQ = (const float*)(P.ws + WS_RQ); const float* RKV = (const float*)(P.ws + WS_RKV);
    if (w < 1280) {
        int c1, c2 = -1;
        if (w < 1024) c1 = 192 * (w >> 7) + (w & 127); else { const int u = w - 1024; c1 = 192 * (u >> 5) + 128 + (u & 31); c2 = c1 + 32; }
        float a1[8] = {0, 0, 0, 0, 0, 0, 0, 0}, a2[8] = {0, 0, 0, 0, 0, 0, 0, 0};
        const bf16_t* A = (const bf16_t*)(P.ws + WS_CQ);
        for (int k = 0; k < QL; ++k) { const float g = P.q_norm_g[k]; const float w1 = P.w_uq[(size_t)k * NUQ + c1] * g, w2 = c2 >= 0 ? P.w_uq[(size_t)k * NUQ + c2] * g : 0.f;
#pragma unroll
            for (int r = 0; r < 8; ++r) { const float a = bf2f(A[(size_t)(row0 + r) * QL + k]); a1[r] += a * w1; a2[r] += a * w2; } }
#pragma unroll
        for (int r = 0; r < 8; ++r) { const int row = row0 + r; const float sc = RQ[row] * SC_B; bf16_t* q = (bf16_t*)(P.ws + WS_QN) + (size_t)row * NUQ;
            if (c2 >= 0) { const int i = (c1 - 128) % 192 & 31; const float cs = COS[row * 32 + i], sn = SIN[row * 32 + i]; const float v1 = a1[r] * sc, v2 = a2[r] * sc;
                q[c1] = f2bf(v1 * cs - v2 * sn); q[c2] = f2bf(v2 * cs + v1 * sn); }
            else q[c1] = f2bf(a1[r] * sc); }
    } else {
        const int c = w - 1280; float a1[8] = {0, 0, 0, 0, 0, 0, 0, 0};
        const bf16_t* A = (const bf16_t*)(P.ws + WS_CKV);
        for (int k = 0; k < KVL; ++k) { const float w1 = P.w_ukv[(size_t)k * NUKV + c] * P.kv_norm_g[k];
#pragma unroll
            for (int r = 0; r < 8; ++r) a1[r] += bf2f(A[(size_t)(row0 + r) * KVL + k]) * w1; }
        const int h = c >> 8, j = c & 255;
#pragma unroll
        for (int r = 0; r < 8; ++r) { const int row = row0 + r; const float v = a1[r] * RKV[row];
            if (j < 128) ((bf16_t*)(P.ws + WS_KN))[(size_t)row * DM + 128 * h + j] = f2bf(v); else ((bf16_t*)(P.ws + WS_VB))[(size_t)row * DM + 128 * h + (j - 128)] = f2bf(v); }
    }
}
__global__ void __launch_bounds__(256) k_n_u(Ptrs P) {
    const int c = blockIdx.x * 256 + threadIdx.x, row0 = blockIdx.y * 8;
    float a1[8] = {0, 0, 0, 0, 0, 0, 0, 0}, a2[8] = {0, 0, 0, 0, 0, 0, 0, 0};
    ndot8<DM>((const bf16_t*)(P.ws + WS_AA), row0, P.w_o_a, DM, c, a1);
    ndot8<DM>((const bf16_t*)(P.ws + WS_AB), row0, P.w_o_b, DM, c, a2);
    const bf16_t* G = (const bf16_t*)P.out;
#pragma unroll
    for (int r = 0; r < 8; ++r) { const int row = row0 + r; ((bf16_t*)(P.ws + WS_U))[(size_t)row * DM + c] = f2bf(bf2f(G[(size_t)row * 2048 + c]) * a1[r] + bf2f(G[(size_t)row * 2048 + 1024 + c]) * a2[r]); }
}
__global__ void __launch_bounds__(256) k_n_y(Ptrs P) {
    const int c = blockIdx.x * 256 + threadIdx.x, row0 = blockIdx.y * 8;
    float a1[8] = {0, 0, 0, 0, 0, 0, 0, 0}, a2[8] = {0, 0, 0, 0, 0, 0, 0, 0};
    ndot8<DM>((const bf16_t*)(P.ws + WS_U), row0, P.w_out, DM, c, a1);
    ndot8<PLE>((const bf16_t*)(P.ws + WS_PB), row0, P.w_pp, DM, c, a2);
    const float* st = (const float*)(P.ws + WS_ESTAT);
#pragma unroll
    for (int r = 0; r < 8; ++r) { const int row = row0 + r; const float xn = (P.x[(size_t)row * DM + c] - st[2 * row]) * st[2 * row + 1] * P.ln_emb_g[c] + P.ln_emb_b[c];
        const float y = ALPHA * xn + a1[r]; ((float*)(P.ws + WS_Y))[(size_t)row * DM + c] = y; ((bf16_t*)(P.ws + WS_YB))[(size_t)row * DM + c] = f2bf(y);
        ((bf16_t*)(P.ws + WS_PP))[(size_t)row * DM + c] = f2bf(a2[r]); }
}
__global__ void __launch_bounds__(256) k_n_y2(Ptrs P) {
    const int c = blockIdx.x * 256 + threadIdx.x, row0 = blockIdx.y * 8;
    float a1[8] = {0, 0, 0, 0, 0, 0, 0, 0};
    ndot8<DM>((const bf16_t*)(P.ws + WS_YB), row0, P.w_pg, DM, c, a1);
#pragma unroll
    for (int r = 0; r < 8; ++r) { const int row = row0 + r; const size_t i = (size_t)row * DM + c;
        P.out[i] = ((const float*)(P.ws + WS_Y))[i] + sigmoidf_(a1[r] + P.b_pg[c]) * bf2f(((const bf16_t*)(P.ws + WS_PP))[i]); }
}
__global__ void k_ln_out(Ptrs P) {
    const int row = blockIdx.x * 4 + (threadIdx.x >> 6), lane = threadIdx.x & 63;
    f32x4* xr = (f32x4*)(P.out + (size_t)row * DM) + lane;
    f32x4 v[4]; float s = 0.f;
#pragma unroll
    for (int j = 0; j < 4; ++j) { v[j] = xr[64 * j]; s += (v[j].x + v[j].y) + (v[j].z + v[j].w); }
    const float mean = wave_sum(s) * (1.f / DM); float s2 = 0.f;
#pragma unroll
    for (int j = 0; j < 4; ++j) { v[j] = v[j] - mean; s2 += (v[j].x * v[j].x + v[j].y * v[j].y) + (v[j].z * v[j].z + v[j].w * v[j].w); }
    const float rstd = 1.f / sqrtf(wave_sum(s2) * (1.f / DM) + LN_EPS);
#pragma unroll
    for (int j = 0; j < 4; ++j) { const int c = 256 * j + 4 * lane; const f32x4 g = *(const f32x4*)(P.ln_post_g + c), b = *(const f32x4*)(P.ln_post_b + c);
        xr[64 * j] = v[j] * rstd * g + b; }
}

extern "C" void kernel_launch(void* const* d_in, const int* in_sizes, int n_in, void* d_out, int out_size, void* d_ws, size_t ws_size, hipStream_t stream) {
    if (n_in != 21 || out_size != T * DM || ws_size < WS_END) { fprintf(stderr, "kernel_launch: unexpected shapes (n_in %d out %d ws %zu)\n", n_in, out_size, ws_size); return; }
    Ptrs P{};
    P.x = (const float*)d_in[0]; P.p = (const float*)d_in[1]; P.pos = (const int*)d_in[2]; P.ln_emb_g = (const float*)d_in[3]; P.ln_emb_b = (const float*)d_in[4];
    P.w_in = (const float*)d_in[5]; P.b_gate = (const float*)d_in[6]; P.diff_lambda = (const float*)d_in[7]; P.subln_g = (const float*)d_in[8]; P.w_o_a = (const float*)d_in[9];
    P.q_norm_g = (const float*)d_in[10]; P.w_uq = (const float*)d_in[11]; P.kv_norm_g = (const float*)d_in[12]; P.w_ukv = (const float*)d_in[13]; P.w_o_b = (const float*)d_in[14];
    P.w_out = (const float*)d_in[15]; P.w_pg = (const float*)d_in[16]; P.b_pg = (const float*)d_in[17]; P.w_pp = (const float*)d_in[18]; P.ln_post_g = (const float*)d_in[19]; P.ln_post_b = (const float*)d_in[20];
    P.out = (float*)d_out; P.ws = (unsigned char*)d_ws;
    k_rope_tab<<<T * 32 / 256, 256, 0, stream>>>(P);
    k_p_bf16<<<T * PLE / 256, 256, 0, stream>>>(P);
    k_ln_emb<<<T / 4, 256, 0, stream>>>(P);
    k_n_win<<<dim3(27, T / 8), 256, 0, stream>>>(P);
    k_n_rstd<<<T / 256, 256, 0, stream>>>(P);
    k_n_attn<0><<<dim3(SEQ / 64, 32), 256, 0, stream>>>(P);
    k_n_up<<<dim3(13, T / 8), 256, 0, stream>>>(P);
    k_n_attn<1><<<dim3(SEQ / 64, 32), 256, 0, stream>>>(P);
    k_n_u<<<dim3(4, T / 8), 256, 0, stream>>>(P);
    k_n_y<<<dim3(4, T / 8), 256, 0, stream>>>(P);
    k_n_y2<<<dim3(4, T / 8), 256, 0, stream>>>(P);
    k_ln_out<<<T / 4, 256, 0, stream>>>(P);
}
```

```cpp
#include <hip/hip_runtime.h>
#include <cstdint>
#include <cstdio>

typedef unsigned short bf16_t;
typedef unsigned u32x4 __attribute__((ext_vector_type(4)));
typedef float f32x4 __attribute__((ext_vector_type(4)));

constexpr int NB = 4, SEQ = 4096, T = NB * SEQ, DM = 1024, PLE = 256, NIN = 7872;
constexpr int C_QA = 0, C_KA = 1024, C_VA = 2048, C_ZA = 3072, C_CQ = 4096, C_CKV = 4480, C_KPE = 4736, C_ZB = 4800, C_G = 5824;
constexpr int QL = 384, KVL = 256, NUQ = 1536, NUKV = 2048;
constexpr float LN_EPS = 1e-5f, RMS_EPS = 1e-6f;
constexpr float LOG2E = 1.4426950408889634f;
constexpr float SC_A = 0.125f * LOG2E;
constexpr float SC_B = 0.07216878364870322f * LOG2E;
constexpr float ALPHA = 1.189207115002721f;
constexpr float LAM_INIT = 0.2f;

constexpr size_t MiB = 1u << 20;
constexpr size_t WS_CTL = 0;
constexpr size_t WS_ESTAT = 1 * MiB;
constexpr size_t WS_RQ = 1 * MiB + 256 * 1024;
constexpr size_t WS_RKV = 1 * MiB + 512 * 1024;
constexpr size_t WS_WOA = 2 * MiB, WS_WOB = 4 * MiB, WS_WOUT = 6 * MiB, WS_WPG = 8 * MiB;
constexpr size_t WS_WUQ = 10 * MiB, WS_WUKV = 11 * MiB + 256 * 1024, WS_WPP = 12 * MiB + 512 * 1024;
constexpr size_t WS_COS = 13 * MiB, WS_SIN = 15 * MiB;
constexpr size_t WS_PB = 17 * MiB;
constexpr size_t WS_KROT = 25 * MiB;
constexpr size_t WS_CQ = 27 * MiB, WS_CKV = 39 * MiB;
constexpr size_t WS_WIN = 47 * MiB;
constexpr size_t WS_XN = 63 * MiB;
constexpr size_t WS_QA = 95 * MiB, WS_KA = 127 * MiB, WS_VA = 159 * MiB, WS_SZA = 191 * MiB, WS_SZB = 223 * MiB;
constexpr size_t WS_AA = WS_QA;
constexpr size_t WS_STASH = WS_XN;
constexpr size_t WS_QN = 127 * MiB;
constexpr size_t WS_KN = 175 * MiB;
constexpr size_t WS_VB = 63 * MiB;
constexpr size_t WS_AB = 27 * MiB;
constexpr size_t WS_U = 127 * MiB;
constexpr size_t WS_Y = 159 * MiB;
constexpr size_t WS_YB = 223 * MiB;
constexpr size_t WS_PP = 63 * MiB;
constexpr size_t WS_END = 255 * MiB;

__device__ __forceinline__ float bf2f(bf16_t v) { return __uint_as_float((unsigned)v << 16); }
__device__ __forceinline__ bf16_t f2bf(float f) { unsigned u = __float_as_uint(f); return (bf16_t)((u + 0x7fffu + ((u >> 16) & 1u)) >> 16); }
__device__ __forceinline__ float sigmoidf_(float v) { return 1.0f / (1.0f + __expf(-v)); }
__device__ __forceinline__ float siluf_(float v) { return v / (1.0f + __expf(-v)); }

__device__ const double INVF[32] = {1.0, 0.7498942093324559, 0.5623413251903491, 0.4216965034285822, 0.31622776601683794, 0.23713737056616552, 0.1778279410038923, 0.1333521432163324, 0.1, 0.07498942093324558, 0.05623413251903491, 0.042169650342858224, 0.03162277660168379, 0.023713737056616554, 0.01778279410038923, 0.01333521432163324, 0.01, 0.007498942093324558, 0.005623413251903491, 0.004216965034285823, 0.0031622776601683794, 0.0023713737056616554, 0.0017782794100389228, 0.001333521432163324, 0.001, 0.0007498942093324559, 0.0005623413251903491, 0.00042169650342858224, 0.00031622776601683794, 0.00023713737056616554, 0.00017782794100389227, 0.0001333521432163324};

__device__ __forceinline__ void rope_cs(int pos, int i, float& c, float& s) {
    const float invf = (float)INVF[i]; const float angf = (float)pos * invf;
    double t = (double)angf * 0.15915494309189535; t -= floor(t);
    const double r = t * 4.0; const double qd = floor(r + 0.5); const double f = (r - qd) * 1.5707963267948966; const int q = ((int)qd) & 3;
    const double f2 = f * f;
    double sp = -1.0 / 6227020800.0; sp = sp * f2 + 1.0 / 39916800.0; sp = sp * f2 - 1.0 / 362880.0; sp = sp * f2 + 1.0 / 5040.0; sp = sp * f2 - 1.0 / 120.0; sp = sp * f2 + 1.0 / 6.0;
    const double sn = f - f * f2 * sp;
    double cp = 1.0 / 87178291200.0; cp = cp * f2 - 1.0 / 479001600.0; cp = cp * f2 + 1.0 / 3628800.0; cp = cp * f2 - 1.0 / 40320.0; cp = cp * f2 + 1.0 / 720.0; cp = cp * f2 - 1.0 / 24.0; cp = cp * f2 + 0.5;
    const double cs = 1.0 - f2 * cp;
    double so, co;
    if (q == 0) { so = sn; co = cs; } else if (q == 1) { so = cs; co = -sn; } else if (q == 2) { so = -sn; co = -cs; } else { so = -cs; co = sn; }
    c = (float)co; s = (float)so;
}

struct Ptrs {
    const float *x, *p; const int* pos; const float *ln_emb_g, *ln_emb_b, *w_in, *b_gate, *diff_lambda, *subln_g, *w_o_a, *q_norm_g, *w_uq, *kv_norm_g, *w_ukv, *w_o_b, *w_out, *w_pg, *b_pg, *w_pp, *ln_post_g, *ln_post_b;
    float* out; unsigned char* ws;
};

__global__ void k_rope_tab(Ptrs P) {
    const int idx = blockIdx.x * blockDim.x + threadIdx.x; if (idx >= T * 32) return;
    const int t = idx >> 5, i = idx & 31; float c, s; rope_cs(P.pos[t], i, c, s);
    ((float*)(P.ws + WS_COS))[idx] = c; ((float*)(P.ws + WS_SIN))[idx] = s;
}
__global__ void k_p_bf16(Ptrs P) {
    const int idx = blockIdx.x * blockDim.x + threadIdx.x; if (idx >= T * PLE) return;
    ((bf16_t*)(P.ws + WS_PB))[idx] = f2bf(P.p[idx]);
}
__device__ __forceinline__ float wave_sum(float v) {
#pragma unroll
    for (int o = 1; o < 64; o <<= 1) v += __shfl_xor(v, o);
    return v;
}
__global__ void k_ln_emb(Ptrs P) {
    const int row = blockIdx.x * 4 + (threadIdx.x >> 6), lane = threadIdx.x & 63;
    const f32x4* xr = (const f32x4*)(P.x + (size_t)row * DM) + lane;
    f32x4 v[4]; float s = 0.f;
#pragma unroll
    for (int j = 0; j < 4; ++j) { v[j] = xr[64 * j]; s += (v[j].x + v[j].y) + (v[j].z + v[j].w); }
    const float mean = wave_sum(s) * (1.f / DM); float s2 = 0.f;
#pragma unroll
    for (int j = 0; j < 4; ++j) { v[j] = v[j] - mean; s2 += (v[j].x * v[j].x + v[j].y * v[j].y) + (v[j].z * v[j].z + v[j].w * v[j].w); }
    const float rstd = 1.f / sqrtf(wave_sum(s2) * (1.f / DM) + LN_EPS);
    bf16_t* o = (bf16_t*)(P.ws + WS_XN) + (size_t)row * DM;
#pragma unroll
    for (int j = 0; j < 4; ++j) { const int c = 256 * j + 4 * lane; const f32x4 g = *(const f32x4*)(P.ln_emb_g + c), b = *(const f32x4*)(P.ln_emb_b + c);
        o[c] = f2bf(v[j].x * rstd * g.x + b.x); o[c + 1] = f2bf(v[j].y * rstd * g.y + b.y); o[c + 2] = f2bf(v[j].z * rstd * g.z + b.z); o[c + 3] = f2bf(v[j].w * rstd * g.w + b.w); }
    if (lane == 0) { float* st = (float*)(P.ws + WS_ESTAT) + 2 * row; st[0] = mean; st[1] = rstd; }
}
template <int K>
__device__ __forceinline__ void ndot8(const bf16_t* __restrict__ A, int row0, const float* __restrict__ W, int ldw, int col, float (&acc)[8]) {
    for (int k = 0; k < K; k += 8) {
        float w[8];
#pragma unroll
        for (int j = 0; j < 8; ++j) w[j] = W[(size_t)(k + j) * ldw + col];
#pragma unroll
        for (int r = 0; r < 8; ++r) { const u32x4 a = *(const u32x4*)(A + (size_t)(row0 + r) * K + k);
            acc[r] += __uint_as_float(a.x << 16) * w[0] + __uint_as_float(a.x & 0xffff0000u) * w[1] + __uint_as_float(a.y << 16) * w[2] + __uint_as_float(a.y & 0xffff0000u) * w[3]
                    + __uint_as_float(a.z << 16) * w[4] + __uint_as_float(a.z & 0xffff0000u) * w[5] + __uint_as_float(a.w << 16) * w[6] + __uint_as_float(a.w & 0xffff0000u) * w[7]; }
    }
}
__global__ void __launch_bounds__(256) k_n_win(Ptrs P) {
    const int w = blockIdx.x * 256 + threadIdx.x, row0 = blockIdx.y * 8; if (w >= 6816) return;
    const bf16_t* XN = (const bf16_t*)(P.ws + WS_XN);
    int c1, c2 = -1;
    if (w < 512) { c1 = C_QA + 64 * (w >> 5) + (w & 31); c2 = c1 + 32; }
    else if (w < 1024) { const int u = w - 512; c1 = C_KA + 64 * (u >> 5) + (u & 31); c2 = c1 + 32; }
    else if (w < 1056) { c1 = C_KPE + (w - 1024); c2 = c1 + 32; }
    else { const int u = w - 1056; c1 = u < 2688 ? C_VA + u : C_ZB + (u - 2688); }
    float a1[8] = {0, 0, 0, 0, 0, 0, 0, 0}, a2[8] = {0, 0, 0, 0, 0, 0, 0, 0};
    ndot8<DM>(XN, row0, P.w_in, NIN, c1, a1);
    if (c2 >= 0) ndot8<DM>(XN, row0, P.w_in, NIN, c2, a2);
    const float* COS = (const float*)(P.ws + WS_COS); const float* SIN = (const float*)(P.ws + WS_SIN);
#pragma unroll
    for (int r = 0; r < 8; ++r) { const int row = row0 + r; const float v = a1[r];
        if (c2 >= 0) { const int i = c1 & 31; const float cs = COS[row * 32 + i], sn = SIN[row * 32 + i]; float o1 = v * cs - a2[r] * sn, o2 = a2[r] * cs + v * sn;
            if (c1 < C_KA) { bf16_t* q = (bf16_t*)(P.ws + WS_QA) + (size_t)row * DM; q[c1] = f2bf(o1 * SC_A); q[c2] = f2bf(o2 * SC_A); }
            else if (c1 < C_VA) { bf16_t* q = (bf16_t*)(P.ws + WS_KA) + (size_t)row * DM; q[c1 - C_KA] = f2bf(o1); q[c2 - C_KA] = f2bf(o2); }
            else { bf16_t* q = (bf16_t*)(P.ws + WS_KROT) + (size_t)row * 64; q[c1 - C_KPE] = f2bf(o1); q[c2 - C_KPE] = f2bf(o2); } }
        else if (c1 < C_ZA) ((bf16_t*)(P.ws + WS_VA))[(size_t)row * DM + (c1 - C_VA)] = f2bf(v);
        else if (c1 < C_CQ) ((bf16_t*)(P.ws + WS_SZA))[(size_t)row * DM + (c1 - C_ZA)] = f2bf(siluf_(v));
        else if (c1 < C_CKV) ((bf16_t*)(P.ws + WS_CQ))[(size_t)row * QL + (c1 - C_CQ)] = f2bf(v);
        else if (c1 < C_KPE) ((bf16_t*)(P.ws + WS_CKV))[(size_t)row * KVL + (c1 - C_CKV)] = f2bf(v);
        else if (c1 < C_G) ((bf16_t*)(P.ws + WS_SZB))[(size_t)row * DM + (c1 - C_ZB)] = f2bf(siluf_(v));
        else ((bf16_t*)P.out)[(size_t)row * 2048 + (c1 - C_G)] = f2bf(sigmoidf_(v + P.b_gate[c1 - C_G])); }
}
__global__ void k_n_rstd(Ptrs P) {
    const int row = blockIdx.x * blockDim.x + threadIdx.x; if (row >= T) return;
    const bf16_t* cq = (const bf16_t*)(P.ws + WS_CQ) + (size_t)row * QL; float s = 0.f;
    for (int k = 0; k < QL; ++k) { const float v = bf2f(cq[k]); s += v * v; }
    ((float*)(P.ws + WS_RQ))[row] = 1.f / sqrtf(s * (1.f / QL) + RMS_EPS);
    const bf16_t* ck = (const bf16_t*)(P.ws + WS_CKV) + (size_t)row * KVL; s = 0.f;
    for (int k = 0; k < KVL; ++k) { const float v = bf2f(ck[k]); s += v * v; }
    ((float*)(P.ws + WS_RKV))[row] = 1.f / sqrtf(s * (1.f / KVL) + RMS_EPS);
}
template <int MODE>
__global__ void __launch_bounds__(256) k_n_attn(Ptrs P) {
    constexpr int DQK = MODE == 0 ? 64 : 192;
    const int bh = blockIdx.y, b = bh >> 3, h = bh & 7, qi = blockIdx.x * 64 + (threadIdx.x >> 2), ch = threadIdx.x & 3;
    const size_t trow = (size_t)b * SEQ + qi;
    const bf16_t* Vb = MODE == 0 ? (const bf16_t*)(P.ws + WS_VA) : (const bf16_t*)(P.ws + WS_VB);
    float o1n[32];
    float lam = 0.f;
    if (MODE == 0) { float s1 = 0.f, s2 = 0.f; for (int k = 0; k < 64; ++k) { s1 += P.diff_lambda[k] * P.diff_lambda[64 + k]; s2 += P.diff_lambda[128 + k] * P.diff_lambda[192 + k]; } lam = __expf(s1) - __expf(s2) + LAM_INIT; }
    constexpr int NPASS = MODE == 0 ? 2 : 1;
    float on[32];
#pragma unroll 1
    for (int pass = 0; pass < NPASS; ++pass) {
        unsigned qp[DQK / 2];
        const bf16_t* qsrc = MODE == 0 ? (const bf16_t*)(P.ws + WS_QA) + trow * DM + 128 * h + 64 * pass : (const bf16_t*)(P.ws + WS_QN) + trow * NUQ + 192 * h;
#pragma unroll
        for (int d = 0; d < DQK / 2; ++d) qp[d] = ((const unsigned*)qsrc)[d];
        float o[32]; float m = -1e30f, l = 0.f;
#pragma unroll
        for (int c = 0; c < 32; ++c) o[c] = 0.f;
        for (int j = 0; j <= qi; ++j) {
            const size_t krow = (size_t)b * SEQ + j; float s = 0.f;
            if (MODE == 0) { const unsigned* kp = (const unsigned*)((const bf16_t*)(P.ws + WS_KA) + krow * DM + 128 * h + 64 * pass);
#pragma unroll
                for (int d = 0; d < 32; ++d) { const unsigned kv = kp[d]; s += __uint_as_float(qp[d] << 16) * __uint_as_float(kv << 16) + __uint_as_float(qp[d] & 0xffff0000u) * __uint_as_float(kv & 0xffff0000u); } }
            else { const unsigned* kp = (const unsigned*)((const bf16_t*)(P.ws + WS_KN) + krow * DM + 128 * h);
#pragma unroll
                for (int d = 0; d < 64; ++d) { const unsigned kv = kp[d]; s += __uint_as_float(qp[d] << 16) * __uint_as_float(kv << 16) + __uint_as_float(qp[d] & 0xffff0000u) * __uint_as_float(kv & 0xffff0000u); }
                const unsigned* kr = (const unsigned*)((const bf16_t*)(P.ws + WS_KROT) + krow * 64);
#pragma unroll
                for (int d = 0; d < 32; ++d) { const unsigned kv = kr[d]; s += __uint_as_float(qp[64 + d] << 16) * __uint_as_float(kv << 16) + __uint_as_float(qp[64 + d] & 0xffff0000u) * __uint_as_float(kv & 0xffff0000u); } }
            const float mn = fmaxf(m, s), corr = exp2f(m - mn), pj = exp2f(s - mn); m = mn; l = l * corr + pj;
            const unsigned* vp = (const unsigned*)(Vb + krow * DM + 128 * h + 32 * ch);
#pragma unroll
            for (int c = 0; c < 16; ++c) { const unsigned vv = vp[c]; o[2 * c] = o[2 * c] * corr + pj * __uint_as_float(vv << 16); o[2 * c + 1] = o[2 * c + 1] * corr + pj * __uint_as_float(vv & 0xffff0000u); }
        }
        const float rl = 1.f / l;
#pragma unroll
        for (int c = 0; c < 32; ++c) { on[c] = o[c] * rl; if (pass == 0) o1n[c] = on[c]; }
    }
    if (MODE == 0) {
        float ss = 0.f;
#pragma unroll
        for (int c = 0; c < 32; ++c) { on[c] = o1n[c] - lam * on[c]; ss += on[c] * on[c]; }
        ss += __shfl_xor(ss, 1); ss += __shfl_xor(ss, 2);
        const float rs = 1.f / sqrtf(ss * (1.f / 128.f) + RMS_EPS);
        const bf16_t* sz = (const bf16_t*)(P.ws + WS_SZA) + trow * DM + 128 * h + 32 * ch; bf16_t* dst = (bf16_t*)(P.ws + WS_AA) + trow * DM + 128 * h + 32 * ch;
#pragma unroll
        for (int c = 0; c < 32; ++c) dst[c] = f2bf(on[c] * rs * P.subln_g[32 * ch + c] * (1.f - LAM_INIT) * bf2f(sz[c]));
    } else {
        const bf16_t* sz = (const bf16_t*)(P.ws + WS_SZB) + trow * DM + 128 * h + 32 * ch; bf16_t* dst = (bf16_t*)(P.ws + WS_AB) + trow * DM + 128 * h + 32 * ch;
#pragma unroll
        for (int c = 0; c < 32; ++c) dst[c] = f2bf(on[c] * bf2f(sz[c]));
    }
}
__global__ void __launch_bounds__(256) k_n_up(Ptrs P) {
    const int w = blockIdx.x * 256 + threadIdx.x, row0 = blockIdx.y * 8;
    if (w >= 1024 + 256 + 2048) return;
    const float* COS = (const float*)(P.ws + WS_COS); const float* SIN = (const float*)(P.ws + WS_SIN);
    const float* RQ = (const float*)(P.ws + WS_RQ); const float* RKV = (const float*)(P.ws + WS_RKV);
    if (w < 1280) {
        int c1, c2 = -1;
        if (w < 1024) c1 = 192 * (w >> 7) + (w & 127); else { const int u = w - 1024; c1 = 192 * (u >> 5) + 128 + (u & 31); c2 = c1 + 32; }
        float a1[8] = {0, 0, 0, 0, 0, 0, 0, 0}, a2[8] = {0, 0, 0, 0, 0, 0, 0, 0};
        const bf16_t* A = (const bf16_t*)(P.ws + WS_CQ);
        for (int k = 0; k < QL; ++k) { const float g = P.q_norm_g[k]; const float w1 = P.w_uq[(size_t)k * NUQ + c1] * g, w2 = c2 >= 0 ? P.w_uq[(size_t)k * NUQ + c2] * g : 0.f;
#pragma unroll
            for (int r = 0; r < 8; ++r) { const float a = bf2f(A[(size_t)(row0 + r) * QL + k]); a1[r] += a * w1; a2[r] += a * w2; } }
#pragma unroll
        for (int r = 0; r < 8; ++r) { const int row = row0 + r; const float sc = RQ[row] * SC_B; bf16_t* q = (bf16_t*)(P.ws + WS_QN) + (size_t)row * NUQ;
            if (c2 >= 0) { const int i = (c1 - 128) % 192 & 31; const float cs = COS[row * 32 + i], sn = SIN[row * 32 + i]; const float v1 = a1[r] * sc, v2 = a2[r] * sc;
                q[c1] = f2bf(v1 * cs - v2 * sn); q[c2] = f2bf(v2 * cs + v1 * sn); }
            else q[c1] = f2bf(a1[r] * sc); }
    } else {
        const int c = w - 1280; float a1[8] = {0, 0, 0, 0, 0, 0, 0, 0};
        const bf16_t* A = (const bf16_t*)(P.ws + WS_CKV);
        for (int k = 0; k < KVL; ++k) { const float w1 = P.w_ukv[(size_t)k * NUKV + c] * P.kv_norm_g[k];
#pragma unroll
            for (int r = 0; r < 8; ++r) a1[r] += bf2f(A[(size_t)(row0 + r) * KVL + k]) * w1; }
        const int h = c >> 8, j = c & 255;
#pragma unroll
        for (int r = 0; r < 8; ++r) { const int row = row0 + r; const float v = a1[r] * RKV[row];
            if (j < 128) ((bf16_t*)(P.ws + WS_KN))[(size_t)row * DM + 128 * h + j] = f2bf(v); else ((bf16_t*)(P.ws + WS_VB))[(size_t)row * DM + 128 * h + (j - 128)] = f2bf(v); }
    }
}
__global__ void __launch_bounds__(256) k_n_u(Ptrs P) {
    const int c = blockIdx.x * 256 + threadIdx.x, row0 = blockIdx.y * 8;
    float a1[8] = {0, 0, 0, 0, 0, 0, 0, 0}, a2[8] = {0, 0, 0, 0, 0, 0, 0, 0};
    ndot8<DM>((const bf16_t*)(P.ws + WS_AA), row0, P.w_o_a, DM, c, a1);
    ndot8<DM>((const bf16_t*)(P.ws + WS_AB), row0, P.w_o_b, DM, c, a2);
    const bf16_t* G = (const bf16_t*)P.out;
#pragma unroll
    for (int r = 0; r < 8; ++r) { const int row = row0 + r; ((bf16_t*)(P.ws + WS_U))[(size_t)row * DM + c] = f2bf(bf2f(G[(size_t)row * 2048 + c]) * a1[r] + bf2f(G[(size_t)row * 2048 + 1024 + c]) * a2[r]); }
}
__global__ void __launch_bounds__(256) k_n_y(Ptrs P) {
    const int c = blockIdx.x * 256 + threadIdx.x, row0 = blockIdx.y * 8;
    float a1[8] = {0, 0, 0, 0, 0, 0, 0, 0}, a2[8] = {0, 0, 0, 0, 0, 0, 0, 0};
    ndot8<DM>((const bf16_t*)(P.ws + WS_U), row0, P.w_out, DM, c, a1);
    ndot8<PLE>((const bf16_t*)(P.ws + WS_PB), row0, P.w_pp, DM, c, a2);
    const float* st = (const float*)(P.ws + WS_ESTAT);
#pragma unroll
    for (int r = 0; r < 8; ++r) { const int row = row0 + r; const float xn = (P.x[(size_t)row * DM + c] - st[2 * row]) * st[2 * row + 1] * P.ln_emb_g[c] + P.ln_emb_b[c];
        const float y = ALPHA * xn + a1[r]; ((float*)(P.ws + WS_Y))[(size_t)row * DM + c] = y; ((bf16_t*)(P.ws + WS_YB))[(size_t)row * DM + c] = f2bf(y);
        ((bf16_t*)(P.ws + WS_PP))[(size_t)row * DM + c] = f2bf(a2[r]); }
}
__global__ void __launch_bounds__(256) k_n_y2(Ptrs P) {
    const int c = blockIdx.x * 256 + threadIdx.x, row0 = blockIdx.y * 8;
    float a1[8] = {0, 0, 0, 0, 0, 0, 0, 0};
    ndot8<DM>((const bf16_t*)(P.ws + WS_YB), row0, P.w_pg, DM, c, a1);
#pragma unroll
    for (int r = 0; r < 8; ++r) { const int row = row0 + r; const size_t i = (size_t)row * DM + c;
        P.out[i] = ((const float*)(P.ws + WS_Y))[i] + sigmoidf_(a1[r] + P.b_pg[c]) * bf2f(((const bf16_t*)(P.ws + WS_PP))[i]); }
}
__global__ void k_ln_out(Ptrs P) {
    const int row = blockIdx.x * 4 + (threadIdx.x >> 6), lane = threadIdx.x & 63;
    f32x4* xr = (f32x4*)(P.out + (size_t)row * DM) + lane;
    f32x4 v[4]; float s = 0.f;
#pragma unroll
    for (int j = 0; j < 4; ++j) { v[j] = xr[64 * j]; s += (v[j].x + v[j].y) + (v[j].z + v[j].w); }
    const float mean = wave_sum(s) * (1.f / DM); float s2 = 0.f;
#pragma unroll
    for (int j = 0; j < 4; ++j) { v[j] = v[j] - mean; s2 += (v[j].x * v[j].x + v[j].y * v[j].y) + (v[j].z * v[j].z + v[j].w * v[j].w); }
    const float rstd = 1.f / sqrtf(wave_sum(s2) * (1.f / DM) + LN_EPS);
#pragma unroll
    for (int j = 0; j < 4; ++j) { const int c = 256 * j + 4 * lane; const f32x4 g = *(const f32x4*)(P.ln_post_g + c), b = *(const f32x4*)(P.ln_post_b + c);
        xr[64 * j] = v[j] * rstd * g + b; }
}

#define FAST_MASK 0x1FFu
#define LAS __attribute__((address_space(3)))
#define GAS __attribute__((address_space(1)))
typedef short bf16x8 __attribute__((ext_vector_type(8)));
typedef short s16x4 __attribute__((ext_vector_type(4)));
typedef float f32x16 __attribute__((ext_vector_type(16)));
typedef float f32x2 __attribute__((ext_vector_type(2)));

__host__ __device__ __forceinline__ int win_real32(int n0v) {
    const int t = n0v >> 8, v = n0v & 255;
    if (t < 8) { const int base = t < 4 ? C_QA + 256 * t : C_KA + 256 * (t - 4); return base + 64 * ((v & 127) >> 5) + (v >= 128 ? 32 : 0); }
    if (t < 12) return C_VA + 256 * (t - 8) + v;
    if (t < 16) return C_ZA + 256 * (t - 12) + v;
    if (t < 20) return C_ZB + 256 * (t - 16) + v;
    if (t < 28) return C_G + 256 * (t - 20) + v;
    if (t == 28) return C_CQ + v;
    if (t == 29) return v < 128 ? C_CQ + 256 + v : C_CKV + (v - 128);
    if (v < 96) return C_CKV + 128 + v;
    if (v == 96) return C_KPE;
    if (v == 128) return C_CKV + 224;
    if (v == 224) return C_KPE + 32;
    return -1;
}
__host__ __device__ __forceinline__ int uq_real32(int n0v) {
    const int t = n0v >> 8, v = n0v & 255;
    if (t < 4) { const int n = n0v; return 192 * (n >> 7) + (n & 127); }
    return 192 * (4 * (t - 4) + ((v & 127) >> 5)) + 128 + (v >= 128 ? 32 : 0);
}

namespace pg8 {
constexpr int BM = 256, BK = 64, HALF = 128, HTB = HALF * BK * 2, STAGE_BYTES = 8 * HTB, NXCD = 8, WGM = 8;
__host__ __device__ __forceinline__ int lds_byte(int r, int c) { const int st = (r >> 4) * 2 + (c >> 5), rr = r & 15, cc = c & 31, ob = rr * 64 + cc * 2; return st * 1024 + (ob ^ (((ob >> 9) & 1) << 5)); }
__host__ __device__ __forceinline__ void stage_rc(int b, int& R, int& C) { const int st = b / 1024, sb = b % 1024, swz = sb ^ (((sb >> 9) & 1) << 5); R = (st >> 1) * 16 + swz / 64; C = (st & 1) * 32 + (swz % 64) / 2; }
__host__ __device__ __forceinline__ int perm32(int rho) { const int n = rho >> 4, i = rho & 15; return 8 * (i >> 2) + 4 * n + (i & 3); }

struct GUnit { const char* A; const char* B; int K; int kind; int pm; int pn; };

__device__ __forceinline__ void tile_of(int L, int nM, int nN, int& pm, int& pn) {
    const int nwg = nM * nN; int wgid = L; { const int q = nwg / NXCD, r = nwg % NXCD, xcd = wgid % NXCD, off = wgid / NXCD; wgid = (xcd < r ? xcd * (q + 1) : r * (q + 1) + (xcd - r) * q) + off; }
    const int nig = WGM * nN, gid = wgid / nig, fm = gid * WGM, gsz = (nM - fm) < WGM ? (nM - fm) : WGM;
    pm = fm + ((wgid % nig) % gsz); pn = (wgid % nig) / gsz;
}

typedef f32x4 Acc[2][2][4][2];
__device__ __forceinline__ unsigned cvt_pk_bf16(float lo, float hi) { unsigned r; asm volatile("v_cvt_pk_bf16_f32 %0, %1, %2" : "=v"(r) : "v"(lo), "v"(hi)); return r; }
__device__ __forceinline__ u32x4 pack8(const f32x4 a, const f32x4 b) { u32x4 w; w.x = cvt_pk_bf16(a[0], a[1]); w.y = cvt_pk_bf16(a[2], a[3]); w.z = cvt_pk_bf16(b[0], b[1]); w.w = cvt_pk_bf16(b[2], b[3]); return w; }
__device__ __forceinline__ void unpack8(const u32x4 w, f32x4& a, f32x4& b) {
    a[0] = __uint_as_float(w.x << 16); a[1] = __uint_as_float(w.x & 0xffff0000u); a[2] = __uint_as_float(w.y << 16); a[3] = __uint_as_float(w.y & 0xffff0000u);
    b[0] = __uint_as_float(w.z << 16); b[1] = __uint_as_float(w.z & 0xffff0000u); b[2] = __uint_as_float(w.w << 16); b[3] = __uint_as_float(w.w & 0xffff0000u); }

template <class Epi, class Sched, bool ALIGN_EPI, bool SP2>
__device__ __forceinline__ void gemm_phase(LAS unsigned char* lds, const Sched& S, const Epi& E) {
    const int tid = threadIdx.x, wid = __builtin_amdgcn_readfirstlane(tid >> 6), lane = tid & 63, wr = wid >> 2, wc = wid & 3, fr = lane & 15, fq = lane >> 4;
    unsigned rA2[2], rB2[2], cc2[2];
#pragma unroll
    for (int i = 0; i < 2; ++i) { int R, C; stage_rc(tid * 16 + i * 8192, R, C); const int Rb = (R & ~31) + perm32(R & 31); rA2[i] = (unsigned)R * 2u; rB2[i] = (unsigned)Rb * 2u; cc2[i] = (unsigned)C * 2u; }
    const size_t kstep = (size_t)(BK * 2);
    const unsigned ldsw = (unsigned)wid * 1024u;
    const int aoff = lds_byte(wr * 64 + fr, fq * 8), boff = lds_byte(wc * 32 + fr, fq * 8);
#define PG8_SA(b, h) (((b) * 2 + (h)) * HTB)
#define PG8_SB(b, h) ((4 + (b) * 2 + (h)) * HTB)
#define PG8_STAGE(bufoff, gbase, voff) do { _Pragma("unroll") for (int _i = 0; _i < 2; ++_i) \
        __builtin_amdgcn_global_load_lds((const unsigned*)((const char*)(gbase) + (voff)[_i]), (LAS unsigned*)(lds + (bufoff) + ldsw + _i * 8192), 16, 0, 0); } while (0)
#define PG8_LDA(dst, b, h) do { _Pragma("unroll") for (int m = 0; m < 4; ++m) _Pragma("unroll") for (int k = 0; k < 2; ++k) dst[m][k] = *(const LAS bf16x8*)(lds + PG8_SA(b, h) + aoff + m * 2048 + k * 1024); } while (0)
#define PG8_LDB(dst, b, h) do { _Pragma("unroll") for (int n = 0; n < 2; ++n) _Pragma("unroll") for (int k = 0; k < 2; ++k) dst[n][k] = *(const LAS bf16x8*)(lds + PG8_SB(b, h) + boff + n * 2048 + k * 1024); } while (0)
#define PG8_MMA(ai, bj, At, Bt) do { __builtin_amdgcn_s_setprio(1); _Pragma("unroll") for (int m = 0; m < 4; ++m) _Pragma("unroll") for (int n = 0; n < 2; ++n) _Pragma("unroll") for (int k = 0; k < 2; ++k) \
        acc[ai][bj][m][n] = __builtin_amdgcn_mfma_f32_16x16x32_bf16(Bt[n][k], At[m][k], acc[ai][bj][m][n], 0, 0, 0); __builtin_amdgcn_s_setprio(0); } while (0)
#define PG8_WAIT_V(n) asm volatile("s_waitcnt vmcnt(" #n ")" ::: "memory")
#define PG8_WAIT_L(n) asm volatile("s_waitcnt lgkmcnt(" #n ")" ::: "memory")
#define PG8_BAR __builtin_amdgcn_s_barrier()
#define PG8_SCHED __builtin_amdgcn_sched_barrier(0)
    GUnit cur, nxt; int ui = 0;
    if (!S.next(0, cur)) return;
    Acc acc;
#pragma unroll
    for (int a = 0; a < 2; ++a)
#pragma unroll
        for (int b = 0; b < 2; ++b)
#pragma unroll
            for (int m = 0; m < 4; ++m)
#pragma unroll
                for (int n = 0; n < 2; ++n) acc[a][b][m][n] = (f32x4){0.f, 0.f, 0.f, 0.f};
    bf16x8 At[4][2], B0[2][2], B1[2][2];
    const char* cA = cur.A; const char* cB = cur.B;
    unsigned voffA[2], voffB[2];
#pragma unroll
    for (int i = 0; i < 2; ++i) { voffA[i] = rA2[i] * (unsigned)cur.K + cc2[i]; voffB[i] = rB2[i] * (unsigned)cur.K + cc2[i]; }
    size_t hstep = (size_t)HALF * cur.K * 2;
    if constexpr (SP2) {
        PG8_STAGE(PG8_SB(0, 0), cB, voffB); PG8_STAGE(PG8_SB(0, 1), cB + hstep, voffB); PG8_STAGE(PG8_SA(0, 0), cA, voffA); PG8_STAGE(PG8_SA(0, 1), cA + hstep, voffA);
        if (wr == 1) PG8_BAR;
        PG8_WAIT_V(2); PG8_BAR;
        PG8_STAGE(PG8_SB(1, 0), cB + kstep, voffB); PG8_STAGE(PG8_SA(1, 0), cA + kstep, voffA); PG8_STAGE(PG8_SB(1, 1), cB + hstep + kstep, voffB);
        PG8_WAIT_V(6); PG8_BAR;
    } else {
        PG8_STAGE(PG8_SB(0, 0), cB, voffB); PG8_STAGE(PG8_SA(0, 0), cA, voffA); PG8_STAGE(PG8_SB(0, 1), cB + hstep, voffB); PG8_STAGE(PG8_SA(0, 1), cA + hstep, voffA);
        if (wr == 1) PG8_BAR;
        PG8_WAIT_V(4); PG8_BAR;
        PG8_STAGE(PG8_SB(1, 0), cB + kstep, voffB); PG8_STAGE(PG8_SA(1, 0), cA + kstep, voffA); PG8_STAGE(PG8_SB(1, 1), cB + hstep + kstep, voffB);
        PG8_WAIT_V(6); PG8_BAR;
    }
    for (;;) {
        const bool has_next = S.next(ui + 1, nxt);
        const char* nA = has_next ? nxt.A : cA; const char* nB = has_next ? nxt.B : cB; const int nK = has_next ? nxt.K : cur.K;
        unsigned nvA[2], nvB[2];
#pragma unroll
        for (int i = 0; i < 2; ++i) { nvA[i] = rA2[i] * (unsigned)nK + cc2[i]; nvB[i] = rB2[i] * (unsigned)nK + cc2[i]; }
        const size_t nh = (size_t)HALF * nK * 2;
        const int nt = cur.K / BK;
        for (int t = 0; t < nt; t += 2) {
            const bool last = (t == nt - 2);
            const char* a1 = cA + (size_t)(t + 1) * kstep;
            const char* a2 = last ? nA : cA + (size_t)(t + 2) * kstep; const char* b2 = last ? nB : cB + (size_t)(t + 2) * kstep;
            const char* a3 = a2 + kstep; const char* b3 = b2 + kstep;
            unsigned vA2[2], vB2[2];
#pragma unroll
            for (int i = 0; i < 2; ++i) { vA2[i] = last ? nvA[i] : voffA[i]; vB2[i] = last ? nvB[i] : voffB[i]; }
            const size_t h2 = last ? nh : hstep;
            if constexpr (SP2) {
            PG8_LDB(B0, 0, 0); PG8_LDB(B1, 0, 1); PG8_SCHED; PG8_LDA(At, 0, 0); PG8_STAGE(PG8_SA(1, 1), a1 + hstep, voffA);
            PG8_WAIT_V(8); PG8_WAIT_L(0); PG8_BAR; PG8_MMA(0, 0, At, B0); PG8_MMA(0, 1, At, B1); PG8_BAR; PG8_SCHED;
            PG8_LDA(At, 0, 1); PG8_STAGE(PG8_SB(0, 0), b2, vB2); PG8_STAGE(PG8_SB(0, 1), b2 + h2, vB2); PG8_STAGE(PG8_SA(0, 0), a2, vA2);
            PG8_WAIT_V(8); PG8_WAIT_L(0); PG8_BAR; PG8_MMA(1, 0, At, B0); PG8_MMA(1, 1, At, B1); PG8_BAR; PG8_SCHED;
            PG8_LDB(B0, 1, 0); PG8_LDB(B1, 1, 1); PG8_SCHED; PG8_LDA(At, 1, 0); PG8_STAGE(PG8_SA(0, 1), a2 + h2, vA2);
            PG8_WAIT_V(8); PG8_WAIT_L(0); PG8_BAR; PG8_MMA(0, 0, At, B0); PG8_MMA(0, 1, At, B1); PG8_BAR; PG8_SCHED;
            PG8_LDA(At, 1, 1); PG8_STAGE(PG8_SB(1, 0), b3, vB2); PG8_STAGE(PG8_SB(1, 1), b3 + h2, vB2); PG8_STAGE(PG8_SA(1, 0), a3, vA2);
            PG8_WAIT_V(8); PG8_WAIT_L(0); PG8_BAR; PG8_MMA(1, 0, At, B0); PG8_MMA(1, 1, At, B1); PG8_BAR; PG8_SCHED;
            } else {
            PG8_LDB(B0, 0, 0); PG8_SCHED; PG8_LDA(At, 0, 0); PG8_STAGE(PG8_SA(1, 1), a1 + hstep, voffA);
            PG8_WAIT_L(8); PG8_BAR; PG8_WAIT_L(0); PG8_MMA(0, 0, At, B0); PG8_BAR; PG8_SCHED;
            PG8_LDB(B1, 0, 1); PG8_STAGE(PG8_SB(0, 0), b2, vB2);
            PG8_BAR; PG8_WAIT_L(0); PG8_MMA(0, 1, At, B1); PG8_BAR;
            PG8_LDA(At, 0, 1); PG8_STAGE(PG8_SA(0, 0), a2, vA2);
            PG8_BAR; PG8_WAIT_L(0); PG8_MMA(1, 0, At, B0); PG8_BAR; PG8_SCHED;
            PG8_STAGE(PG8_SB(0, 1), b2 + h2, vB2);
            PG8_WAIT_V(6); PG8_BAR; PG8_MMA(1, 1, At, B1); PG8_BAR;
            PG8_LDB(B0, 1, 0); PG8_SCHED; PG8_LDA(At, 1, 0); PG8_STAGE(PG8_SA(0, 1), a2 + h2, vA2);
            PG8_WAIT_L(8); PG8_BAR; PG8_WAIT_L(0); PG8_MMA(0, 0, At, B0); PG8_BAR; PG8_SCHED;
            PG8_LDB(B1, 1, 1); PG8_STAGE(PG8_SB(1, 0), b3, vB2);
            PG8_BAR; PG8_WAIT_L(0); PG8_MMA(0, 1, At, B1); PG8_BAR;
            PG8_LDA(At, 1, 1); PG8_STAGE(PG8_SA(1, 0), a3, vA2);
            PG8_BAR; PG8_WAIT_L(0); PG8_MMA(1, 0, At, B0); PG8_BAR; PG8_SCHED;
            PG8_STAGE(PG8_SB(1, 1), b3 + h2, vB2);
            PG8_WAIT_V(6); PG8_BAR; PG8_MMA(1, 1, At, B1); PG8_BAR;
            }
        }
        if constexpr (ALIGN_EPI) { if (wr == 0) PG8_BAR; }
        const bool keep = E(acc, cur, wr, wc, fr, fq);
        if (!has_next) break;
        if (!keep) {
#pragma unroll
        for (int a = 0; a < 2; ++a)
#pragma unroll
            for (int b = 0; b < 2; ++b)
#pragma unroll
                for (int m = 0; m < 4; ++m)
#pragma unroll
                    for (int n = 0; n < 2; ++n) acc[a][b][m][n] = (f32x4){0.f, 0.f, 0.f, 0.f};
        }
        cur = nxt; cA = nA; cB = nB; hstep = nh; ++ui;
#pragma unroll
        for (int i = 0; i < 2; ++i) { voffA[i] = nvA[i]; voffB[i] = nvB[i]; }
        if constexpr (ALIGN_EPI) { if (wr == 1) PG8_BAR; }
    }
    PG8_WAIT_V(0);
    if constexpr (!ALIGN_EPI) { if (wr == 0) PG8_BAR; }
    PG8_BAR;
#undef PG8_SA
#undef PG8_SB
#undef PG8_STAGE
#undef PG8_LDA
#undef PG8_LDB
#undef PG8_MMA
#undef PG8_WAIT_V
#undef PG8_WAIT_L
#undef PG8_BAR
#undef PG8_SCHED
}

__device__ __forceinline__ void st16(bf16_t* p, const f32x4 a, const f32x4 b) { *(u32x4*)p = pack8(a, b); }
__device__ __forceinline__ f32x4 silu4(const f32x4 v) { f32x4 o; for (int j = 0; j < 4; ++j) o[j] = v[j] * __builtin_amdgcn_rcpf(1.0f + __builtin_amdgcn_exp2f(-LOG2E * v[j])); return o; }
__device__ __forceinline__ f32x4 sigm4(const f32x4 v) { f32x4 o; for (int j = 0; j < 4; ++j) o[j] = __builtin_amdgcn_rcpf(1.0f + __builtin_amdgcn_exp2f(-LOG2E * v[j])); return o; }

struct EpiP1 {
    unsigned char* ws; bf16_t* G; const float* b_gate;
    __device__ __forceinline__ bool operator()(Acc& acc, const GUnit& u, int wr, int wc, int fr, int fq) const {
        const int pn = u.pn, row0 = u.pm * BM + wr * 64 + fr, vc0 = wc * 32 + 8 * fq;
        const float* COS = (const float*)(ws + WS_COS); const float* SIN = (const float*)(ws + WS_SIN);
        if (pn < 8 || (pn == 30 && wc == 3)) {
            bf16_t* dst; int pitch, c1; float sc = 1.f;
            if (pn < 4) { dst = (bf16_t*)(ws + WS_QA); pitch = DM; c1 = 256 * pn + 64 * wc + 8 * fq; sc = SC_A; }
            else if (pn < 8) { dst = (bf16_t*)(ws + WS_KA); pitch = DM; c1 = 256 * (pn - 4) + 64 * wc + 8 * fq; }
            else { dst = (bf16_t*)(ws + WS_KROT); pitch = 64; c1 = 8 * fq; }
#pragma unroll
            for (int ai = 0; ai < 2; ++ai)
#pragma unroll
                for (int m = 0; m < 4; ++m) { const int row = row0 + ai * HALF + m * 16;
                    const f32x4 c0 = *(const f32x4*)(COS + row * 32 + 8 * fq), c1v = *(const f32x4*)(COS + row * 32 + 8 * fq + 4), s0 = *(const f32x4*)(SIN + row * 32 + 8 * fq), s1 = *(const f32x4*)(SIN + row * 32 + 8 * fq + 4);
                    const f32x4 x10 = acc[ai][0][m][0], x11 = acc[ai][0][m][1], x20 = acc[ai][1][m][0], x21 = acc[ai][1][m][1];
                    bf16_t* rp = dst + (size_t)row * pitch + c1;
                    st16(rp, (x10 * c0 - x20 * s0) * sc, (x11 * c1v - x21 * s1) * sc);
                    st16(rp + 32, (x20 * c0 + x10 * s0) * sc, (x21 * c1v + x11 * s1) * sc); }
            if (pn < 8) return false;
        }
        if (pn >= 8 && pn < 28) {
            bf16_t* dst; int pitch = DM, cb; int op = 0;
            if (pn < 12) { dst = (bf16_t*)(ws + WS_VA); cb = 256 * (pn - 8); }
            else if (pn < 16) { dst = (bf16_t*)(ws + WS_SZA); cb = 256 * (pn - 12); op = 1; }
            else if (pn < 20) { dst = (bf16_t*)(ws + WS_SZB); cb = 256 * (pn - 16); op = 1; }
            else { dst = G; pitch = 2048; cb = 256 * (pn - 20); op = 2; }
#pragma unroll
            for (int bj = 0; bj < 2; ++bj) { const int col = cb + 128 * bj + vc0;
                f32x4 b0 = (f32x4){0.f, 0.f, 0.f, 0.f}, b1 = b0; if (op == 2) { b0 = *(const f32x4*)(b_gate + col); b1 = *(const f32x4*)(b_gate + col + 4); }
#pragma unroll
                for (int ai = 0; ai < 2; ++ai)
#pragma unroll
                    for (int m = 0; m < 4; ++m) { const int row = row0 + ai * HALF + m * 16; f32x4 v0 = acc[ai][bj][m][0], v1 = acc[ai][bj][m][1];
                        if (op == 1) { v0 = silu4(v0); v1 = silu4(v1); } else if (op == 2) { v0 = sigm4(v0 + b0); v1 = sigm4(v1 + b1); }
                        st16(dst + (size_t)row * pitch + col, v0, v1); } }
            return false;
        }
#pragma unroll
        for (int bj = 0; bj < 2; ++bj) {
            bf16_t* dst = nullptr; int pitch = QL, col = 0;
            if (pn == 28) { dst = (bf16_t*)(ws + WS_CQ); col = 128 * bj + vc0; }
            else if (pn == 29) { if (bj == 0) { dst = (bf16_t*)(ws + WS_CQ); col = 256 + vc0; } else { dst = (bf16_t*)(ws + WS_CKV); pitch = KVL; col = vc0; } }
            else { if (bj == 0) { if (wc < 3) { dst = (bf16_t*)(ws + WS_CKV); pitch = KVL; col = 128 + vc0; } } else { if (wc == 0) { dst = (bf16_t*)(ws + WS_CKV); pitch = KVL; col = 224 + vc0; } } }
            if (dst) {
#pragma unroll
                for (int ai = 0; ai < 2; ++ai)
#pragma unroll
                    for (int m = 0; m < 4; ++m) { const int row = row0 + ai * HALF + m * 16; st16(dst + (size_t)row * pitch + col, acc[ai][bj][m][0], acc[ai][bj][m][1]); } }
        }
        return false;
    }
};
struct EpiP3 {
    unsigned char* ws;
    __device__ __forceinline__ bool operator()(Acc& acc, const GUnit& u, int wr, int wc, int fr, int fq) const {
        const int pn = u.pn, row0 = u.pm * BM + wr * 64 + fr, vc0 = wc * 32 + 8 * fq;
        if (u.kind == 0) {
            const float* RQ = (const float*)(ws + WS_RQ); bf16_t* QN = (bf16_t*)(ws + WS_QN);
            if (pn < 4) {
#pragma unroll
                for (int ai = 0; ai < 2; ++ai)
#pragma unroll
                    for (int m = 0; m < 4; ++m) { const int row = row0 + ai * HALF + m * 16; const float sc = RQ[row] * SC_B;
#pragma unroll
                        for (int bj = 0; bj < 2; ++bj) st16(QN + (size_t)row * NUQ + 192 * (2 * pn + bj) + vc0, acc[ai][bj][m][0] * sc, acc[ai][bj][m][1] * sc); }
            } else {
                const float* COS = (const float*)(ws + WS_COS); const float* SIN = (const float*)(ws + WS_SIN);
                const int head = 4 * (pn - 4) + wc;
#pragma unroll
                for (int ai = 0; ai < 2; ++ai)
#pragma unroll
                    for (int m = 0; m < 4; ++m) { const int row = row0 + ai * HALF + m * 16; const float sc = RQ[row] * SC_B;
                        const f32x4 c0 = *(const f32x4*)(COS + row * 32 + 8 * fq), c1v = *(const f32x4*)(COS + row * 32 + 8 * fq + 4), s0 = *(const f32x4*)(SIN + row * 32 + 8 * fq), s1 = *(const f32x4*)(SIN + row * 32 + 8 * fq + 4);
                        const f32x4 x10 = acc[ai][0][m][0] * sc, x11 = acc[ai][0][m][1] * sc, x20 = acc[ai][1][m][0] * sc, x21 = acc[ai][1][m][1] * sc;
                        bf16_t* rp = QN + (size_t)row * NUQ + 192 * head + 128 + 8 * fq;
                        st16(rp, x10 * c0 - x20 * s0, x11 * c1v - x21 * s1);
                        st16(rp + 32, x20 * c0 + x10 * s0, x21 * c1v + x11 * s1); }
            }
        } else {
            const float* RKV = (const float*)(ws + WS_RKV);
#pragma unroll
            for (int ai = 0; ai < 2; ++ai)
#pragma unroll
                for (int m = 0; m < 4; ++m) { const int row = row0 + ai * HALF + m * 16; const float sc = RKV[row];
                    st16((bf16_t*)(ws + WS_KN) + (size_t)row * DM + 128 * pn + vc0, acc[ai][0][m][0] * sc, acc[ai][0][m][1] * sc);
                    st16((bf16_t*)(ws + WS_VB) + (size_t)row * DM + 128 * pn + vc0, acc[ai][1][m][0] * sc, acc[ai][1][m][1] * sc); }
        }
        return false;
    }
};
struct EpiP5 {
    unsigned char* ws; const bf16_t* G;
    __device__ __forceinline__ bool operator()(Acc& acc, const GUnit& u, int wr, int wc, int fr, int fq) const {
        const int row0 = u.pm * BM + wr * 64 + fr, col0 = u.pn * BM + wc * 32 + 8 * fq;
#pragma unroll
        for (int ai = 0; ai < 2; ++ai)
#pragma unroll
            for (int m = 0; m < 4; ++m) { const int row = row0 + ai * HALF + m * 16;
#pragma unroll
                for (int bj = 0; bj < 2; ++bj) { const int col = col0 + 128 * bj;
                    f32x4 gb0, gb1; unpack8(*(const u32x4*)(G + (size_t)row * 2048 + 1024 + col), gb0, gb1);
                    if (u.kind == 0) { f32x4 ga0, ga1; unpack8(*(const u32x4*)(G + (size_t)row * 2048 + col), ga0, ga1);
#pragma unroll
                        for (int j = 0; j < 4; ++j) { acc[ai][bj][m][0][j] *= ga0[j] * __builtin_amdgcn_rcpf(fmaxf(gb0[j], 1e-20f)); acc[ai][bj][m][1][j] *= ga1[j] * __builtin_amdgcn_rcpf(fmaxf(gb1[j], 1e-20f)); } }
                    else { f32x4 a0, a1;
#pragma unroll
                        for (int j = 0; j < 4; ++j) { a0[j] = acc[ai][bj][m][0][j] * fmaxf(gb0[j], 1e-20f); a1[j] = acc[ai][bj][m][1][j] * fmaxf(gb1[j], 1e-20f); }
                        st16((bf16_t*)(ws + WS_U) + (size_t)row * DM + col, a0, a1); } } }
        return u.kind == 0;
    }
};
struct EpiP6 {
    unsigned char* ws; const float* x; const float* g; const float* b;
    __device__ __forceinline__ bool operator()(Acc& acc, const GUnit& u, int wr, int wc, int fr, int fq) const {
        const int row0 = u.pm * BM + wr * 64 + fr, col0 = u.pn * BM + wc * 32 + 8 * fq;
        if (u.kind == 1) {
#pragma unroll
            for (int ai = 0; ai < 2; ++ai)
#pragma unroll
                for (int m = 0; m < 4; ++m) { const int row = row0 + ai * HALF + m * 16;
#pragma unroll
                    for (int bj = 0; bj < 2; ++bj) st16((bf16_t*)(ws + WS_PP) + (size_t)row * DM + col0 + 128 * bj, acc[ai][bj][m][0], acc[ai][bj][m][1]); }
            return false;
        }
        const float* st = (const float*)(ws + WS_ESTAT);
#pragma unroll
        for (int bj = 0; bj < 2; ++bj) { const int col = col0 + 128 * bj;
            const f32x4 g0 = *(const f32x4*)(g + col), g1 = *(const f32x4*)(g + col + 4), b0 = *(const f32x4*)(b + col), b1 = *(const f32x4*)(b + col + 4);
#pragma unroll
            for (int ai = 0; ai < 2; ++ai)
#pragma unroll
                for (int m = 0; m < 4; ++m) { const int row = row0 + ai * HALF + m * 16; const f32x2 ms = *(const f32x2*)(st + 2 * row);
                    const size_t off = (size_t)row * DM + col; const f32x4 x0 = *(const f32x4*)(x + off), x1 = *(const f32x4*)(x + off + 4);
                    const f32x4 y0 = ((x0 - ms.x) * ms.y * g0 + b0) * ALPHA + acc[ai][bj][m][0], y1 = ((x1 - ms.x) * ms.y * g1 + b1) * ALPHA + acc[ai][bj][m][1];
                    *(f32x4*)((float*)(ws + WS_Y) + off) = y0; *(f32x4*)((float*)(ws + WS_Y) + off + 4) = y1;
                    st16((bf16_t*)(ws + WS_YB) + off, y0, y1); } }
        return false;
    }
};
struct EpiP7 {
    unsigned char* ws; const float* bias; float* out;
    __device__ __forceinline__ bool operator()(Acc& acc, const GUnit& u, int wr, int wc, int fr, int fq) const {
        const int row0 = u.pm * BM + wr * 64 + fr, col0 = u.pn * BM + wc * 32 + 8 * fq;
#pragma unroll
        for (int bj = 0; bj < 2; ++bj) { const int col = col0 + 128 * bj;
            const f32x4 b0 = *(const f32x4*)(bias + col), b1 = *(const f32x4*)(bias + col + 4);
#pragma unroll
            for (int ai = 0; ai < 2; ++ai)
#pragma unroll
                for (int m = 0; m < 4; ++m) { const int row = row0 + ai * HALF + m * 16; const size_t off = (size_t)row * DM + col;
                    f32x4 p0, p1; unpack8(*(const u32x4*)((const bf16_t*)(ws + WS_PP) + off), p0, p1);
                    const f32x4 y0 = *(const f32x4*)((const float*)(ws + WS_Y) + off), y1 = *(const f32x4*)((const float*)(ws + WS_Y) + off + 4);
                    *(f32x4*)(out + off) = y0 + sigm4(acc[ai][bj][m][0] + b0) * p0; *(f32x4*)(out + off + 4) = y1 + sigm4(acc[ai][bj][m][1] + b1) * p1; } }
        return false;
    }
};
struct SchedP1 { int G, c; unsigned char* ws;
    __device__ __forceinline__ bool next(int i, GUnit& u) const { const int L = i * G + c; if (L >= 64 * 31) return false; tile_of(L, 64, 31, u.pm, u.pn);
        u.A = (const char*)(ws + WS_XN) + (size_t)u.pm * 256 * DM * 2; u.B = (const char*)(ws + WS_WIN) + (size_t)u.pn * 256 * DM * 2; u.K = DM; u.kind = 0; return true; } };
struct SchedP3 { int c; unsigned char* ws;
    __device__ __forceinline__ bool next(int i, GUnit& u) const {
        int kind, idx;
        if (c < 128) { if (i >= 3) return false; kind = i < 2 ? 0 : 1; idx = i == 0 ? c : (i == 1 ? 256 + c : c); }
        else { if (i >= 4) return false; kind = i == 0 ? 0 : 1; idx = i == 0 ? c : 128 + 3 * (c - 128) + (i - 1); }
        u.kind = kind;
        if (kind == 0) { u.pm = idx / 6; u.pn = idx % 6; u.K = QL; u.A = (const char*)(ws + WS_CQ) + (size_t)u.pm * 256 * QL * 2; u.B = (const char*)(ws + WS_WUQ) + (size_t)u.pn * 256 * QL * 2; }
        else { u.pm = idx >> 3; u.pn = idx & 7; u.K = KVL; u.A = (const char*)(ws + WS_CKV) + (size_t)u.pm * 256 * KVL * 2; u.B = (const char*)(ws + WS_WUKV) + (size_t)u.pn * 256 * KVL * 2; }
        return true; } };
struct SchedP5 { int c; unsigned char* ws;
    __device__ __forceinline__ bool next(int i, GUnit& u) const { if (i >= 2) return false; tile_of(c, 64, 4, u.pm, u.pn); u.K = DM; u.kind = i;
        u.A = (const char*)(ws + (i == 0 ? WS_AA : WS_AB)) + (size_t)u.pm * 256 * DM * 2; u.B = (const char*)(ws + (i == 0 ? WS_WOA : WS_WOB)) + (size_t)u.pn * 256 * DM * 2; return true; } };
struct SchedP6 { int c; unsigned char* ws;
    __device__ __forceinline__ bool next(int i, GUnit& u) const { if (i >= 2) return false; tile_of(c, 64, 4, u.pm, u.pn);
        if (i == 0) { u.kind = 1; u.K = PLE; u.A = (const char*)(ws + WS_PB) + (size_t)u.pm * 256 * PLE * 2; u.B = (const char*)(ws + WS_WPP) + (size_t)u.pn * 256 * PLE * 2; }
        else { u.kind = 0; u.K = DM; u.A = (const char*)(ws + WS_U) + (size_t)u.pm * 256 * DM * 2; u.B = (const char*)(ws + WS_WOUT) + (size_t)u.pn * 256 * DM * 2; }
        return true; } };
struct SchedP7 { int c; unsigned char* ws;
    __device__ __forceinline__ bool next(int i, GUnit& u) const { if (i >= 1) return false; tile_of(c, 64, 4, u.pm, u.pn); u.kind = 0; u.K = DM;
        u.A = (const char*)(ws + WS_YB) + (size_t)u.pm * 256 * DM * 2; u.B = (const char*)(ws + WS_WPG) + (size_t)u.pn * 256 * DM * 2; return true; } };
}

namespace att {
#define SBAR() __builtin_amdgcn_sched_barrier(0)
constexpr float THR = 8.f;
__device__ __forceinline__ int crow(int r, int hi) { return (r & 3) + 8 * (r >> 2) + 4 * hi; }
__device__ __forceinline__ unsigned cvtpk(float lo, float hi) { unsigned r; asm volatile("v_cvt_pk_bf16_f32 %0, %1, %2" : "=v"(r) : "v"(lo), "v"(hi)); return r; }
__device__ __forceinline__ int v_st(int k, int c) { const int kk = (k & ~0xC) | ((k & 4) << 1) | ((k & 8) >> 1); return ((kk >> 3) * 4 + (c >> 5)) * 512 + ((kk & 7) * 32 + (c & 31)) * 2; }
__device__ __forceinline__ int v_rd_base(int lane) { return ((lane & 3) << 3) | (((lane >> 2) & 3) << 6) | (((lane >> 4) & 1) << 5) | (((lane >> 5) & 1) << 8); }
constexpr int v_rd_off(int d0, int ks, int half) { return d0 * 512 + ks * 4096 + half * 2048; }
typedef short v4i16_t __attribute__((ext_vector_type(4)));
__device__ __forceinline__ s16x4 vtr(LAS const unsigned char* p) { return __builtin_bit_cast(s16x4, __builtin_amdgcn_ds_read_tr16_b64_v4i16((LAS v4i16_t*)p)); }

template <int DQK> struct Lay { static constexpr int KB = 64 * DQK * 2, VBY = 16384, OFF_K = 0, OFF_V = 2 * KB, OFF_WS = 2 * KB + 2 * VBY, BYTES = OFF_WS + 8 * 256; };

struct EpiArgs { float* stash; const bf16_t* sz; bf16_t* dst; const float* subg; float lam; };

template <int DQK, int MODE>
__device__ __forceinline__ void attn_unit(LAS unsigned char* lds, const bf16_t* Qb, int qpitch, const bf16_t* K1b, const bf16_t* K2b,
                                          const bf16_t* Vb, int q0, const EpiArgs& E) {
    typedef Lay<DQK> L; constexpr int ND = DQK / 16, NKI = DQK / 64, NC1 = (MODE == 2) ? 16 : 8;
    const int tid = threadIdx.x, lane = tid & 63, r32 = lane & 31, hi = lane >> 5; const int wid = __builtin_amdgcn_readfirstlane(tid >> 6);
    const int NT = (q0 + 256) / 64;
    LAS float* wsf = (LAS float*)(lds + L::OFF_WS) + wid * 64;
    bf16x8 qr[ND];
#pragma unroll
    for (int d0 = 0; d0 < ND; ++d0) qr[d0] = *(const bf16x8*)(Qb + (size_t)(q0 + wid * 32 + r32) * qpitch + d0 * 16 + hi * 8);
    LAS const unsigned char* vb0 = lds + L::OFF_V + v_rd_base(lane);
    LAS const unsigned char* kb0 = lds + L::OFF_K + hi * 1024 + r32 * 16;
    const int vkk = 8 * wid + ((lane & 31) >> 2), vk = (vkk & ~0xC) | ((vkk & 4) << 1) | ((vkk & 8) >> 1);
    const bf16_t* vsrc = Vb + (size_t)vk * DM + (lane >> 5) * 32 + (lane & 3) * 8;
    const bf16_t* ksrc = K1b + (size_t)lane * DM + 8 * wid;
    const bf16_t* k2src = K2b + (size_t)lane * 64 + 8 * wid;
#define ST_DMA(t, bf) do { const size_t to_ = (size_t)(t) * 64 * DM; \
        __builtin_amdgcn_global_load_lds((const unsigned*)(ksrc + to_), (LAS unsigned*)(lds + L::OFF_K + (bf) * L::KB + wid * 1024), 16, 0, 0); \
        if (NKI > 1) __builtin_amdgcn_global_load_lds((const unsigned*)(ksrc + to_ + 64), (LAS unsigned*)(lds + L::OFF_K + (bf) * L::KB + (wid + 8) * 1024), 16, 0, 0); \
        if (NKI > 2) __builtin_amdgcn_global_load_lds((const unsigned*)(k2src + (size_t)(t) * 64 * 64), (LAS unsigned*)(lds + L::OFF_K + (bf) * L::KB + (wid + 16) * 1024), 16, 0, 0); \
        __builtin_amdgcn_global_load_lds((const unsigned*)(vsrc + to_), (LAS unsigned*)(lds + L::OFF_V + (bf) * L::VBY + (2 * wid) * 1024), 16, 0, 0); \
        __builtin_amdgcn_global_load_lds((const unsigned*)(vsrc + to_ + 64), (LAS unsigned*)(lds + L::OFF_V + (bf) * L::VBY + (2 * wid + 1) * 1024), 16, 0, 0); } while (0)
    float m_reg = -1e30f, l_reg = 0.f; f32x16 o[4];
#pragma unroll
    for (int d = 0; d < 4; ++d) o[d] = f32x16{};
    const int qrow = q0 + wid * 32 + r32;
    ST_DMA(0, 0); __syncthreads();
#define STEP(t, BUF) do { \
        const bool more_ = (t) + 1 < NT; \
        if (more_) ST_DMA((t) + 1, (BUF) ^ 1); \
        f32x16 p0 = f32x16{}, p1 = f32x16{}; \
        _Pragma("unroll") for (int d0 = 0; d0 < ND; ++d0) { \
            const bf16x8 b0 = *(LAS const bf16x8*)(kb0 + (BUF) * L::KB + d0 * 2048), b1 = *(LAS const bf16x8*)(kb0 + (BUF) * L::KB + d0 * 2048 + 512); \
            p0 = __builtin_amdgcn_mfma_f32_32x32x16_bf16(b0, qr[d0], p0, 0, 0, 0); p1 = __builtin_amdgcn_mfma_f32_32x32x16_bf16(b1, qr[d0], p1, 0, 0, 0); } \
        if ((t) * 64 + 63 > q0 + wid * 32) { const int kb_ = (t) * 64 + 4 * hi; \
            _Pragma("unroll") for (int r = 0; r < 16; ++r) { const int kv_ = kb_ + (r & 3) + 8 * (r >> 2); if (kv_ > qrow) p0[r] = -__builtin_inff(); if (kv_ + 32 > qrow) p1[r] = -__builtin_inff(); } } \
        float pmax = p0[0]; \
        _Pragma("unroll") for (int r = 1; r < 16; ++r) pmax = fmaxf(pmax, p0[r]); \
        _Pragma("unroll") for (int r = 0; r < 16; ++r) pmax = fmaxf(pmax, p1[r]); \
        { auto rr = __builtin_amdgcn_permlane32_swap(__float_as_uint(pmax), __float_as_uint(pmax), false, false); pmax = fmaxf(__uint_as_float(rr[0]), __uint_as_float(rr[1])); } \
        float alpha = 1.f; bool resc = false; \
        if (!__all(pmax - m_reg <= THR)) { const float mn = fmaxf(m_reg, pmax); alpha = __builtin_amdgcn_exp2f(m_reg - mn); m_reg = mn; resc = true; } \
        _Pragma("unroll") for (int r = 0; r < 16; ++r) { p0[r] = __builtin_amdgcn_exp2f(p0[r] - m_reg); p1[r] = __builtin_amdgcn_exp2f(p1[r] - m_reg); } \
        float ps = 0.f; \
        _Pragma("unroll") for (int r = 0; r < 16; ++r) ps += p0[r]; \
        _Pragma("unroll") for (int r = 0; r < 16; ++r) ps += p1[r]; \
        { auto rr = __builtin_amdgcn_permlane32_swap(__float_as_uint(ps), __float_as_uint(ps), false, false); ps = __uint_as_float(rr[0]) + __uint_as_float(rr[1]); } \
        l_reg = l_reg * alpha + ps; \
        bf16x8 pa0, pa1, pa2, pa3; \
        PK4(p0, 0, pa0); PK4(p0, 8, pa1); PK4(p1, 0, pa2); PK4(p1, 8, pa3); \
        if (resc) { if (hi == 0) wsf[r32] = alpha; asm volatile("s_waitcnt lgkmcnt(0)" ::: "memory"); \
            _Pragma("unroll") for (int r = 0; r < 16; ++r) { const float a_ = wsf[crow(r, hi)]; o[0][r] *= a_; o[1][r] *= a_; o[2][r] *= a_; o[3][r] *= a_; } } \
        _Pragma("unroll") for (int d0 = 0; d0 < 4; ++d0) { \
            s16x4 l0 = vtr(vb0 + (BUF) * L::VBY + v_rd_off(d0, 0, 0)), h0 = vtr(vb0 + (BUF) * L::VBY + v_rd_off(d0, 0, 1)), l1 = vtr(vb0 + (BUF) * L::VBY + v_rd_off(d0, 1, 0)), h1 = vtr(vb0 + (BUF) * L::VBY + v_rd_off(d0, 1, 1)); \
            s16x4 l2 = vtr(vb0 + (BUF) * L::VBY + v_rd_off(d0, 2, 0)), h2 = vtr(vb0 + (BUF) * L::VBY + v_rd_off(d0, 2, 1)), l3 = vtr(vb0 + (BUF) * L::VBY + v_rd_off(d0, 3, 0)), h3 = vtr(vb0 + (BUF) * L::VBY + v_rd_off(d0, 3, 1)); \
            o[d0] = __builtin_amdgcn_mfma_f32_32x32x16_bf16(pa0, (bf16x8){l0[0], l0[1], l0[2], l0[3], h0[0], h0[1], h0[2], h0[3]}, o[d0], 0, 0, 0); \
            o[d0] = __builtin_amdgcn_mfma_f32_32x32x16_bf16(pa1, (bf16x8){l1[0], l1[1], l1[2], l1[3], h1[0], h1[1], h1[2], h1[3]}, o[d0], 0, 0, 0); \
            o[d0] = __builtin_amdgcn_mfma_f32_32x32x16_bf16(pa2, (bf16x8){l2[0], l2[1], l2[2], l2[3], h2[0], h2[1], h2[2], h2[3]}, o[d0], 0, 0, 0); \
            o[d0] = __builtin_amdgcn_mfma_f32_32x32x16_bf16(pa3, (bf16x8){l3[0], l3[1], l3[2], l3[3], h3[0], h3[1], h3[2], h3[3]}, o[d0], 0, 0, 0); } \
        __syncthreads(); } while (0)
#define PK4(P, B_, OUT) do { const unsigned a0_ = cvtpk(P[B_ + 0], P[B_ + 1]), a1_ = cvtpk(P[B_ + 2], P[B_ + 3]), b0_ = cvtpk(P[B_ + 4], P[B_ + 5]), b1_ = cvtpk(P[B_ + 6], P[B_ + 7]); \
        auto r0_ = __builtin_amdgcn_permlane32_swap(a0_, b0_, false, false); auto r1_ = __builtin_amdgcn_permlane32_swap(a1_, b1_, false, false); \
        u32x4 w_ = {r0_[0], r1_[0], r0_[1], r1_[1]}; OUT = __builtin_bit_cast(bf16x8, w_); } while (0)
    for (int t = 0; t < NT; t += 2) { STEP(t, 0); STEP(t + 1, 1); }
#undef STEP
#undef PK4
#undef ST_DMA
    if (hi == 0) wsf[32 + r32] = l_reg; asm volatile("s_waitcnt lgkmcnt(0)" ::: "memory");
    float rli[16];
#pragma unroll
    for (int r = 0; r < 16; ++r) rli[r] = __builtin_amdgcn_rcpf(wsf[32 + crow(r, hi)]);
    if (MODE == 0) {
        float* sp = E.stash + ((size_t)(blockIdx.x * 8 + wid) * 64) * 64 + lane;
#pragma unroll
        for (int d0 = 0; d0 < 4; ++d0)
#pragma unroll
            for (int r = 0; r < 16; ++r) sp[(d0 * 16 + r) * 64] = o[d0][r] * rli[r];
    } else {
        float sc[16];
        if (MODE == 1) {
            const float* sp = E.stash + ((size_t)(blockIdx.x * 8 + wid) * 64) * 64 + lane;
#pragma unroll
            for (int r = 0; r < 16; ++r) { float q = 0.f;
#pragma unroll
                for (int d0 = 0; d0 < 4; ++d0) { const float v = sp[(d0 * 16 + r) * 64] - E.lam * (o[d0][r] * rli[r]); o[d0][r] = v; q += v * v; }
                q += __shfl_xor(q, 1); q += __shfl_xor(q, 2); q += __shfl_xor(q, 4); q += __shfl_xor(q, 8); q += __shfl_xor(q, 16);
                sc[r] = (1.f - LAM_INIT) / sqrtf(q * (1.f / 128.f) + RMS_EPS); }
        } else {
#pragma unroll
            for (int r = 0; r < 16; ++r) sc[r] = rli[r];
        }
#pragma unroll
        for (int d0 = 0; d0 < 4; ++d0) { const float g = MODE == 1 ? E.subg[32 * d0 + r32] : 1.f;
#pragma unroll
            for (int r = 0; r < 16; ++r) { const size_t off = (size_t)(q0 + wid * 32 + crow(r, hi)) * DM + 32 * d0 + r32;
                const float v = o[d0][r] * sc[r] * g * bf2f(E.sz[off]); const float vn = __shfl_xor(v, 1);
                if ((r32 & 1) == 0) *(unsigned*)(E.dst + off) = cvtpk(v, vn); } }
    }
    __syncthreads();
}
#undef SBAR
}
constexpr int NWAVES = 8;
constexpr int RING_OFF = 0, RING_BYTES = 131072;
constexpr int LDSCTL_OFF = RING_BYTES, MISC_OFF = LDSCTL_OFF + 320;
constexpr int LDS_BYTES = 147456;
constexpr size_t CTL_ZERO_BYTES = 256 * 1024;
constexpr int CW_BAR = 4096;

#define XB_TMO      128
#define XB_XCNT(j)  (256  + 64 * (j))
#define XB_XSUB(j)  (1280 + 64 * (j))
#define XB_XGEN(j)  (2304 + 64 * (j))
#define XB_TOP      3328
#define XB_TOPGEN   3392
#define XCD_BAR_WORDS 3456
#define XB_SPIN_CAP (1u << 18)
__device__ __forceinline__ unsigned xb_ld(unsigned* p)              { return __hip_atomic_load(p, __ATOMIC_RELAXED, __HIP_MEMORY_SCOPE_AGENT); }
__device__ __forceinline__ unsigned xb_add(unsigned* p, unsigned v) { return __hip_atomic_fetch_add(p, v, __ATOMIC_RELAXED, __HIP_MEMORY_SCOPE_AGENT); }
__device__ __forceinline__ unsigned xb_xcc_id() { return (unsigned)__builtin_amdgcn_s_getreg((3 << 11) | 20) & 0xFu; }
#define XB_SPIN(cond, bar) do { unsigned _sp = 0; while (cond) { __builtin_amdgcn_s_sleep(1); \
    if ((++_sp & 255u) == 0u) { if (xb_ld(&(bar)[XB_TMO])) break; if (_sp > XB_SPIN_CAP) { atomicAdd(&(bar)[XB_TMO], 1u); break; } } } } while (0)
struct XcdBarrier { unsigned* bar; unsigned x; volatile LAS unsigned* st; };
__device__ __forceinline__ XcdBarrier xcd_barrier_post(unsigned* bar, volatile LAS unsigned* st) {
    XcdBarrier b; b.bar = bar; b.x = xb_xcc_id(); b.st = st;
    if (threadIdx.x == 0) (void)xb_add(&bar[XB_XCNT(b.x)], 1u);
    return b;
}
__device__ __forceinline__ void xcd_barrier_complete(unsigned* bar, unsigned x, unsigned& nloc, unsigned& nx) {
    const unsigned G = gridDim.x * gridDim.y * gridDim.z;
    unsigned sum, cnt, mine, sp = 0u;
    for (;;) {
        sum = 0u; cnt = 0u; mine = 0u;
#pragma unroll
        for (unsigned j = 0; j < 16; ++j) { const unsigned c = xb_ld(&bar[XB_XCNT(j)]); sum += c; cnt += (c > 0u) ? 1u : 0u; mine = (j == x) ? c : mine; }
        if (sum == G) break;
        __builtin_amdgcn_s_sleep(1);
        if ((++sp & 255u) == 0u) { if (xb_ld(&bar[XB_TMO])) break; if (sp > XB_SPIN_CAP) { atomicAdd(&bar[XB_TMO], 1u); break; } }
    }
    nloc = mine > 0u ? mine : 1u; nx = cnt > 0u ? cnt : 1u;
}
__device__ __forceinline__ void xcd_barrier(const XcdBarrier& b) {
    asm volatile("s_waitcnt vmcnt(0)" ::: "memory");
    __syncthreads();
    if (threadIdx.x == 0) {
        unsigned* bar = b.bar;
        __builtin_amdgcn_s_waitcnt(0);
        unsigned nloc = b.st[0], nx = b.st[1];
        if (nloc == 0u) { xcd_barrier_complete(bar, b.x, nloc, nx); b.st[0] = nloc; b.st[1] = nx; }
        const unsigned old = xb_add(&bar[XB_XSUB(b.x)], 1u);
        const unsigned gen = old / nloc;
        if (old + 1u == (gen + 1u) * nloc) {
            __builtin_amdgcn_fence(__ATOMIC_RELEASE, "agent");
            asm volatile("s_waitcnt vmcnt(0)" ::: "memory");
            const unsigned og = xb_add(&bar[XB_TOP], 1u);
            const unsigned tg = og / nx;
            if (og + 1u == (tg + 1u) * nx) xb_add(&bar[XB_TOPGEN], 1u);
            else XB_SPIN(xb_ld(&bar[XB_TOPGEN]) == tg, bar);
            __builtin_amdgcn_fence(__ATOMIC_ACQUIRE, "agent");
            xb_add(&bar[XB_XGEN(b.x)], 1u);
            asm volatile("s_waitcnt vmcnt(0)" ::: "memory");
        } else {
            XB_SPIN(xb_ld(&bar[XB_XGEN(b.x)]) == gen, bar);
            __builtin_amdgcn_fence(__ATOMIC_ACQUIRE, "agent");
            asm volatile("s_waitcnt vmcnt(0)" ::: "memory");
        }
    }
    __syncthreads();
}

__device__ __forceinline__ void p0_transpose_item(const float* W, int srcN, int K, bf16_t* WT, int n0v, int n0real, int k0, const float* gk, LAS float* scr, int lane) {
#pragma unroll 8
    for (int i = 0; i < 32; ++i) { const int kk = 2 * i + (lane >> 5); float v = 0.f;
        if (n0real >= 0) { v = W[(size_t)(k0 + kk) * srcN + n0real + (lane & 31)]; if (gk) v *= gk[k0 + kk]; }
        scr[kk * 33 + (lane & 31)] = v; }
    asm volatile("s_waitcnt lgkmcnt(0)" ::: "memory");
    const int c = lane & 7;
#pragma unroll
    for (int j = 0; j < 4; ++j) { const int n = (lane >> 3) + 8 * j; const LAS float* s = scr + (8 * c) * 33 + n;
        u32x4 o; o.x = (unsigned)f2bf(s[0 * 33]) | ((unsigned)f2bf(s[1 * 33]) << 16); o.y = (unsigned)f2bf(s[2 * 33]) | ((unsigned)f2bf(s[3 * 33]) << 16);
        o.z = (unsigned)f2bf(s[4 * 33]) | ((unsigned)f2bf(s[5 * 33]) << 16); o.w = (unsigned)f2bf(s[6 * 33]) | ((unsigned)f2bf(s[7 * 33]) << 16);
        *(u32x4*)(WT + (size_t)(n0v + n) * K + k0 + 8 * c) = o; }
    asm volatile("s_waitcnt lgkmcnt(0)" ::: "memory");
}
__device__ __forceinline__ void p0_prologue(const Ptrs& P, LAS unsigned char* lds, int vcu, int G, int wave, int lane) {
    LAS float* scr = (LAS float*)(lds + RING_OFF + wave * 16384);
    const int gw = vcu * NWAVES + wave, NGW = G * NWAVES;
    unsigned char* ws = P.ws;
    constexpr int I_IN = 16 * 248, I_SQ = 16 * 32, I_UQ = 6 * 48, I_UKV = 4 * 64, I_PP = 4 * 32;
    constexpr int NITEMS = I_IN + 4 * I_SQ + I_UQ + I_UKV + I_PP;
    for (int it = gw; it < NITEMS; it += NGW) {
        int r = it;
        if (r < I_IN) { const int kb = r / 248, nb = r % 248; p0_transpose_item(P.w_in, NIN, DM, (bf16_t*)(ws + WS_WIN), 32 * nb, win_real32(32 * nb), 64 * kb, nullptr, scr, lane); continue; } r -= I_IN;
        if (r < 4 * I_SQ) { const int w = r / I_SQ, q = r % I_SQ, kb = q / 32, nb = q % 32;
            const float* src = w == 0 ? P.w_o_a : (w == 1 ? P.w_o_b : (w == 2 ? P.w_out : P.w_pg)); bf16_t* dst = (bf16_t*)(ws + (w == 0 ? WS_WOA : (w == 1 ? WS_WOB : (w == 2 ? WS_WOUT : WS_WPG))));
            p0_transpose_item(src, DM, DM, dst, 32 * nb, 32 * nb, 64 * kb, nullptr, scr, lane); continue; } r -= 4 * I_SQ;
        if (r < I_UQ) { const int kb = r / 48, nb = r % 48; p0_transpose_item(P.w_uq, NUQ, QL, (bf16_t*)(ws + WS_WUQ), 32 * nb, uq_real32(32 * nb), 64 * kb, P.q_norm_g, scr, lane); continue; } r -= I_UQ;
        if (r < I_UKV) { const int kb = r / 64, nb = r % 64; p0_transpose_item(P.w_ukv, NUKV, KVL, (bf16_t*)(ws + WS_WUKV), 32 * nb, 32 * nb, 64 * kb, P.kv_norm_g, scr, lane); continue; } r -= I_UKV;
        { const int kb = r / 32, nb = r % 32; p0_transpose_item(P.w_pp, DM, PLE, (bf16_t*)(ws + WS_WPP), 32 * nb, 32 * nb, 64 * kb, nullptr, scr, lane); }
    }
    for (int row = gw; row < T; row += NGW) {
        const f32x4* xr = (const f32x4*)(P.x + (size_t)row * DM) + lane;
        f32x4 v[4]; float s = 0.f;
#pragma unroll
        for (int j = 0; j < 4; ++j) { v[j] = xr[64 * j]; s += (v[j].x + v[j].y) + (v[j].z + v[j].w); }
        const float mean = wave_sum(s) * (1.f / DM); float s2 = 0.f;
#pragma unroll
        for (int j = 0; j < 4; ++j) { v[j] = v[j] - mean; s2 += (v[j].x * v[j].x + v[j].y * v[j].y) + (v[j].z * v[j].z + v[j].w * v[j].w); }
        const float rstd = 1.f / sqrtf(wave_sum(s2) * (1.f / DM) + LN_EPS);
        bf16_t* o = (bf16_t*)(ws + WS_XN) + (size_t)row * DM;
#pragma unroll
        for (int j = 0; j < 4; ++j) { const int c = 256 * j + 4 * lane; const f32x4 g = *(const f32x4*)(P.ln_emb_g + c), b = *(const f32x4*)(P.ln_emb_b + c); const f32x4 y = v[j] * rstd * g + b;
            unsigned long long w = (unsigned long long)((unsigned)f2bf(y.x) | ((unsigned)f2bf(y.y) << 16)) | ((unsigned long long)((unsigned)f2bf(y.z) | ((unsigned)f2bf(y.w) << 16)) << 32);
            *(unsigned long long*)(o + c) = w; }
        if (lane == 0) { float* st = (float*)(ws + WS_ESTAT) + 2 * row; st[0] = mean; st[1] = rstd; }
    }
    { const int gt = gw * 64 + lane, NGT = NGW * 64;
      for (int i = gt; i < T * PLE / 8; i += NGT) { const f32x4 a = *(const f32x4*)(P.p + (size_t)i * 8), b = *(const f32x4*)(P.p + (size_t)i * 8 + 4);
          u32x4 o; o.x = (unsigned)f2bf(a.x) | ((unsigned)f2bf(a.y) << 16); o.y = (unsigned)f2bf(a.z) | ((unsigned)f2bf(a.w) << 16); o.z = (unsigned)f2bf(b.x) | ((unsigned)f2bf(b.y) << 16); o.w = (unsigned)f2bf(b.z) | ((unsigned)f2bf(b.w) << 16);
          *(u32x4*)((bf16_t*)(ws + WS_PB) + (size_t)i * 8) = o; }
      for (int i = gt; i < T * 32; i += NGT) { float c, s; rope_cs(P.pos[i >> 5], i & 31, c, s); ((float*)(ws + WS_COS))[i] = c; ((float*)(ws + WS_SIN))[i] = s; } }
}

struct Args { Ptrs P; int ph_lo, ph_hi, li, pad; };

__global__ void __launch_bounds__(NWAVES * 64, 2) mega_fwd(Args args) {
    extern __shared__ __attribute__((aligned(16))) unsigned char lds_raw[];
    LAS unsigned char* lds = (LAS unsigned char*)lds_raw;
    volatile LAS unsigned* MISC = (volatile LAS unsigned*)(lds + MISC_OFF);
    const int tid = threadIdx.x, lane = tid & 63, wave = __builtin_amdgcn_readfirstlane(tid >> 6);
    const int G = gridDim.x; const int bx = blockIdx.x; const int vcu = (G % 8 == 0) ? (bx % 8) * (G / 8) + bx / 8 : bx;
    const Ptrs& P = args.P; unsigned char* ws = P.ws;
    for (int u = tid; u < (LDS_BYTES - LDSCTL_OFF) / 4; u += NWAVES * 64) ((LAS unsigned*)(lds + LDSCTL_OFF))[u] = 0u;
    __syncthreads();
    XcdBarrier bar = xcd_barrier_post((unsigned*)(ws + WS_CTL) + CW_BAR + args.li * XCD_BAR_WORDS, MISC + 8);
    const int lo = args.ph_lo, hi = args.ph_hi;
#define IN(k) (lo <= (k) && (k) < hi)
#define BOTH(k) (IN(k) && IN((k) + 1))
#define GRID_BAR() xcd_barrier(bar)

#ifndef NO_P0
    if (IN(0)) { p0_prologue(P, lds, vcu, G, wave, lane); if (BOTH(0)) GRID_BAR(); }
#endif

#ifndef NO_P1
    if (IN(1)) {
        pg8::SchedP1 S{G, bx, ws}; pg8::EpiP1 E{ws, (bf16_t*)P.out, P.b_gate};
        pg8::gemm_phase<pg8::EpiP1, pg8::SchedP1, true, true>(lds + RING_OFF, S, E);
        if (BOTH(1)) GRID_BAR();
    }
#endif

#ifndef NO_P2
    if (IN(2)) {
        { const int gw = vcu * NWAVES + wave, NGW = G * NWAVES;
          for (int row = gw; row < T; row += NGW) {
              float s = 0.f;
              if (lane < 48) { const u32x4 w = *(const u32x4*)((const bf16_t*)(ws + WS_CQ) + (size_t)row * QL + 8 * lane); f32x4 a, b; pg8::unpack8(w, a, b);
                  s = (a[0] * a[0] + a[1] * a[1]) + (a[2] * a[2] + a[3] * a[3]) + (b[0] * b[0] + b[1] * b[1]) + (b[2] * b[2] + b[3] * b[3]); }
              s = wave_sum(s);
              float s2 = 0.f;
              if (lane < 32) { const u32x4 w = *(const u32x4*)((const bf16_t*)(ws + WS_CKV) + (size_t)row * KVL + 8 * lane); f32x4 a, b; pg8::unpack8(w, a, b);
                  s2 = (a[0] * a[0] + a[1] * a[1]) + (a[2] * a[2] + a[3] * a[3]) + (b[0] * b[0] + b[1] * b[1]) + (b[2] * b[2] + b[3] * b[3]); }
              s2 = wave_sum(s2);
              if (lane == 0) { ((float*)(ws + WS_RQ))[row] = 1.f / sqrtf(s * (1.f / QL) + RMS_EPS); ((float*)(ws + WS_RKV))[row] = 1.f / sqrtf(s2 * (1.f / KVL) + RMS_EPS); } } }
        float lam;
        { const float a = P.diff_lambda[lane] * P.diff_lambda[64 + lane], b = P.diff_lambda[128 + lane] * P.diff_lambda[192 + lane]; lam = expf(wave_sum(a)) - expf(wave_sum(b)) + LAM_INIT; }
        const int bh = vcu >> 3, s = vcu & 7, b = bh >> 3, h = bh & 7;
        if (G == 256) {
#pragma unroll 1
            for (int i = 0; i < 2; ++i) { const int qb = i == 0 ? s : 15 - s;
                const size_t boff = (size_t)b * SEQ * DM + 128 * h;
                att::EpiArgs E{(float*)(ws + WS_STASH), (const bf16_t*)(ws + WS_SZA) + boff, (bf16_t*)(ws + WS_AA) + boff, P.subln_g, lam};
                att::attn_unit<64, 0>(lds + RING_OFF, (const bf16_t*)(ws + WS_QA) + boff, DM, (const bf16_t*)(ws + WS_KA) + boff, nullptr, (const bf16_t*)(ws + WS_VA) + boff, qb * 256, E);
                att::attn_unit<64, 1>(lds + RING_OFF, (const bf16_t*)(ws + WS_QA) + boff + 64, DM, (const bf16_t*)(ws + WS_KA) + boff + 64, nullptr, (const bf16_t*)(ws + WS_VA) + boff, qb * 256, E); }
        }
        if (BOTH(2)) GRID_BAR();
    }
#endif

#ifndef NO_P3
    if (IN(3)) {
        pg8::SchedP3 S{bx, ws}; pg8::EpiP3 E{ws};
        if (G == 256) pg8::gemm_phase<pg8::EpiP3, pg8::SchedP3, true, true>(lds + RING_OFF, S, E);
        if (BOTH(3)) GRID_BAR();
    }
#endif

#ifndef NO_P4
    if (IN(4)) {
        const int bh = vcu >> 3, s = vcu & 7, b = bh >> 3, h = bh & 7;
        if (G == 256) {
#pragma unroll 1
            for (int i = 0; i < 2; ++i) { const int qb = i == 0 ? s : 15 - s;
                const size_t boff = (size_t)b * SEQ * DM + 128 * h;
                att::EpiArgs E{nullptr, (const bf16_t*)(ws + WS_SZB) + boff, (bf16_t*)(ws + WS_AB) + boff, nullptr, 0.f};
                att::attn_unit<192, 2>(lds + RING_OFF, (const bf16_t*)(ws + WS_QN) + (size_t)b * SEQ * NUQ + 192 * h, NUQ, (const bf16_t*)(ws + WS_KN) + boff, (const bf16_t*)(ws + WS_KROT) + (size_t)b * SEQ * 64,
                                       (const bf16_t*)(ws + WS_VB) + boff, qb * 256, E); }
        }
        if (BOTH(4)) GRID_BAR();
    }
#endif

#ifndef NO_P5
    if (IN(5)) {
        pg8::SchedP5 S{bx, ws}; pg8::EpiP5 E{ws, (const bf16_t*)P.out};
        if (G == 256) pg8::gemm_phase<pg8::EpiP5, pg8::SchedP5, true, true>(lds + RING_OFF, S, E);
        if (BOTH(5)) GRID_BAR();
    }
#endif
#ifndef NO_P6
    if (IN(6)) {
        pg8::SchedP6 S{bx, ws}; pg8::EpiP6 E{ws, P.x, P.ln_emb_g, P.ln_emb_b};
        if (G == 256) pg8::gemm_phase<pg8::EpiP6, pg8::SchedP6, true, true>(lds + RING_OFF, S, E);
        if (BOTH(6)) GRID_BAR();
    }
#endif
#ifndef NO_P7
    if (IN(7)) {
        pg8::SchedP7 S{bx, ws}; pg8::EpiP7 E{ws, P.b_pg, P.out};
        if (G == 256) pg8::gemm_phase<pg8::EpiP7, pg8::SchedP7, true, true>(lds + RING_OFF, S, E);
        if (BOTH(7)) GRID_BAR();
    }
#endif
#ifndef NO_P8
    if (IN(8)) {
        const int gw = vcu * NWAVES + wave, NGW = G * NWAVES;
        for (int row = gw; row < T; row += NGW) {
            f32x4* xr = (f32x4*)(P.out + (size_t)row * DM) + lane;
            f32x4 v[4]; float s = 0.f;
#pragma unroll
            for (int j = 0; j < 4; ++j) { v[j] = xr[64 * j]; s += (v[j].x + v[j].y) + (v[j].z + v[j].w); }
            const float mean = wave_sum(s) * (1.f / DM); float s2 = 0.f;
#pragma unroll
            for (int j = 0; j < 4; ++j) { v[j] = v[j] - mean; s2 += (v[j].x * v[j].x + v[j].y * v[j].y) + (v[j].z * v[j].z + v[j].w * v[j].w); }
            const float rstd = 1.f / sqrtf(wave_sum(s2) * (1.f / DM) + LN_EPS);
#pragma unroll
            for (int j = 0; j < 4; ++j) { const int c = 256 * j + 4 * lane; const f32x4 g = *(const f32x4*)(P.ln_post_g + c), b = *(const f32x4*)(P.ln_post_b + c); xr[64 * j] = v[j] * rstd * g + b; }
        }
    }
#endif
#undef IN
#undef BOTH
#undef GRID_BAR
}

#ifndef FAST_MASK
#define FAST_MASK 0x1FFu
#endif
static void launch_naive_phase(int k, const Ptrs& P, hipStream_t stream) {
    switch (k) {
    case 0: k_rope_tab<<<T * 32 / 256, 256, 0, stream>>>(P); k_p_bf16<<<T * PLE / 256, 256, 0, stream>>>(P); k_ln_emb<<<T / 4, 256, 0, stream>>>(P); break;
    case 1: k_n_win<<<dim3(27, T / 8), 256, 0, stream>>>(P); break;
    case 2: k_n_rstd<<<T / 256, 256, 0, stream>>>(P); k_n_attn<0><<<dim3(SEQ / 64, 32), 256, 0, stream>>>(P); break;
    case 3: k_n_up<<<dim3(13, T / 8), 256, 0, stream>>>(P); break;
    case 4: k_n_attn<1><<<dim3(SEQ / 64, 32), 256, 0, stream>>>(P); break;
    case 5: k_n_u<<<dim3(4, T / 8), 256, 0, stream>>>(P); break;
    case 6: k_n_y<<<dim3(4, T / 8), 256, 0, stream>>>(P); break;
    case 7: k_n_y2<<<dim3(4, T / 8), 256, 0, stream>>>(P); break;
    default: k_ln_out<<<T / 4, 256, 0, stream>>>(P); break;
    }
}
extern "C" void kernel_launch(void* const* d_in, const int* in_sizes, int n_in, void* d_out, int out_size, void* d_ws, size_t ws_size, hipStream_t stream) {
    static int grid = 0;
    if (grid == 0) {
        if (n_in != 21 || out_size != T * DM || ws_size < WS_END) { fprintf(stderr, "kernel_launch: unexpected shapes (n_in %d out %d ws %zu)\n", n_in, out_size, ws_size); grid = -1; return; }
        int dev = 0, cus = 0;
        if (hipGetDevice(&dev) != hipSuccess || hipDeviceGetAttribute(&cus, hipDeviceAttributeMultiprocessorCount, dev) != hipSuccess) { grid = -1; return; }
        if (hipFuncSetAttribute((const void*)mega_fwd, hipFuncAttributeMaxDynamicSharedMemorySize, LDS_BYTES) != hipSuccess) { fprintf(stderr, "kernel_launch: hipFuncSetAttribute failed\n"); grid = -1; return; }
        (void)hipGetLastError();
        grid = cus;
    }
    if (grid < 0) return;
    Args a{};
    Ptrs& P = a.P;
    P.x = (const float*)d_in[0]; P.p = (const float*)d_in[1]; P.pos = (const int*)d_in[2]; P.ln_emb_g = (const float*)d_in[3]; P.ln_emb_b = (const float*)d_in[4];
    P.w_in = (const float*)d_in[5]; P.b_gate = (const float*)d_in[6]; P.diff_lambda = (const float*)d_in[7]; P.subln_g = (const float*)d_in[8]; P.w_o_a = (const float*)d_in[9];
    P.q_norm_g = (const float*)d_in[10]; P.w_uq = (const float*)d_in[11]; P.kv_norm_g = (const float*)d_in[12]; P.w_ukv = (const float*)d_in[13]; P.w_o_b = (const float*)d_in[14];
    P.w_out = (const float*)d_in[15]; P.w_pg = (const float*)d_in[16]; P.b_pg = (const float*)d_in[17]; P.w_pp = (const float*)d_in[18]; P.ln_post_g = (const float*)d_in[19]; P.ln_post_b = (const float*)d_in[20];
    P.out = (float*)d_out; P.ws = (unsigned char*)d_ws;
    (void)hipMemsetAsync((char*)d_ws + WS_CTL, 0, CTL_ZERO_BYTES, stream);
    int li = 0;
    for (int k = 0; k < 9;) {
        if ((FAST_MASK >> k) & 1u) { int e = k; while (e < 9 && ((FAST_MASK >> e) & 1u)) ++e;
            a.ph_lo = k; a.ph_hi = e; a.li = li++;
            hipLaunchKernelGGL(mega_fwd, dim3(grid), dim3(NWAVES * 64), LDS_BYTES, stream, a);
            k = e; }
        else { launch_naive_phase(k, P, stream); ++k; }
    }
}
```
